# Optimizing an MI355X kernel written in HIP

```python
import math
import jax, jax.numpy as jnp
from jax import lax
import numpy as np

D_MODEL = 1024
BATCH = 8
SEQ = 2048
DEPTH = 4

CHUNK = 64
N_MIXERS = 4
ALPHA = (2.0 * DEPTH) ** 0.25
BETA = (8.0 * DEPTH) ** -0.25
LN_EPS = 1e-5

CONV_A_WIDTH = 3

RWKV_HEAD = 64
RWKV_HEADS = D_MODEL // RWKV_HEAD
RWKV_DECAY_LORA = 64
RWKV_AAA_LORA = 64
RWKV_GATE_LORA = 160
RWKV_GN_EPS = 64e-5
RWKV_N_MIX = 6

D_RNN = 1280
LRU_BLOCKS = 10
LRU_BW = D_RNN // LRU_BLOCKS
CONV_C_WIDTH = 4
LRU_C = 8.0

RET_HEADS = 4
RET_DK = D_MODEL // RET_HEADS
RET_DV = 2 * D_MODEL // RET_HEADS
ROPE_BASE = 10000.0
RET_GN_EPS = 1e-6

D_FF = 2816
N_EXPERTS = 8
TOP_K = 2
D_FF_EXPERT = 3584
N_DENSE = (DEPTH + 1) // 2
N_MOE = DEPTH // 2

kernel_name = "hybrid_streaming_encoder_trunk"


def layer_norm(x, g, b, eps=LN_EPS):
    xf = x.astype(jnp.float32)
    mu = jnp.mean(xf, -1, keepdims=True)
    var = jnp.mean(jnp.square(xf - mu), -1, keepdims=True)
    return ((xf - mu) * lax.rsqrt(var + eps) * g + b).astype(x.dtype)


def group_norm_heads(y, g, b, eps):
    yf = y.astype(jnp.float32)
    mu = jnp.mean(yf, -1, keepdims=True)
    var = jnp.mean(jnp.square(yf - mu), -1, keepdims=True)
    return (yf - mu) * lax.rsqrt(var + eps) * g + b


def head_rms_norm(y, eps):
    yf = y.astype(jnp.float32)
    return yf * lax.rsqrt(jnp.mean(jnp.square(yf), -1, keepdims=True) + eps)


def causal_dwconv(x, w):
    K = w.shape[0]
    S = x.shape[1]
    xp = jnp.pad(x, ((0, 0), (K - 1, 0), (0, 0)))
    return sum(xp[:, k:k + S] * w[k] for k in range(K))


def token_shift(x):
    return jnp.pad(x, ((0, 0), (1, 0), (0, 0)))[:, :-1]


def rotary(t, positions):
    half = t.shape[-1] // 2
    freq = ROPE_BASE ** -jnp.linspace(0.0, 1.0, half, dtype=jnp.float32)
    ang = positions.astype(jnp.float32)[..., None] * freq
    cos = jnp.cos(ang)[:, :, None, :]
    sin = jnp.sin(ang)[:, :, None, :]
    tf = t.astype(jnp.float32)
    t1, t2 = tf[..., :half], tf[..., half:]
    return jnp.concatenate([t1 * cos - t2 * sin, t1 * sin + t2 * cos], axis=-1)


def linear_recurrence(a, b):
    def combine(left, right):
        a_l, b_l = left
        a_r, b_r = right
        return a_l * a_r, a_r * b_l + b_r
    _, h = lax.associative_scan(combine, (a, b), axis=1)
    return h


def short_conv_mixer(x, w_in, conv_w, w_out):
    b_gate, c_gate, v = jnp.split(x @ w_in, 3, axis=-1)
    y = b_gate * causal_dwconv(c_gate * v, conv_w)
    return y @ w_out


def rwkv7_scan(r, w, k, v, a, b):
    Bsz, S, H, N = r.shape

    def step(state, inp):
        r_t, w_t, k_t, v_t, a_t, b_t = inp
        sa = jnp.einsum('bhvk,bhk->bhv', state, a_t)
        state = (state * w_t[:, :, None, :]
                 + sa[..., None] * b_t[:, :, None, :]
                 + v_t[..., None] * k_t[:, :, None, :])
        return state, jnp.einsum('bhvk,bhk->bhv', state, r_t)

    xs = tuple(jnp.moveaxis(t, 1, 0) for t in (r, w, k, v, a, b))
    s0 = jnp.zeros((Bsz, H, N, N), jnp.float32)
    _, y = lax.scan(step, s0, xs)
    return jnp.moveaxis(y, 0, 1)


def rwkv7_mixer(x, mix, w_r, w_k, w_v, w0, w1, w2, a0, a1, a2, g1, g2,
                k_k, k_a, r_k, gn_g, gn_b, w_o):
    Bsz, S, D = x.shape
    H, N = RWKV_HEADS, RWKV_HEAD
    xx = token_shift(x) - x
    xr, xw, xk, xv, xa, xg = (x + xx * mix[j] for j in range(RWKV_N_MIX))

    r = xr @ w_r
    w_log = -jax.nn.softplus(-(w0 + jnp.tanh(xw @ w1) @ w2)) - 0.5
    k = xk @ w_k
    v = xv @ w_v
    a = jax.nn.sigmoid(a0 + (xa @ a1) @ a2)
    g = jax.nn.sigmoid(xg @ g1) @ g2

    heads = lambda t: t.astype(jnp.float32).reshape(Bsz, S, H, N)
    kk = heads(k * k_k)
    kk = kk / jnp.maximum(jnp.sqrt(jnp.sum(jnp.square(kk), -1, keepdims=True)), 1e-12)
    k = k * (1 + (a - 1) * k_a)

    rh, kh, vh, ah = heads(r), heads(k), heads(v), heads(a)
    decay = jnp.exp(-jnp.exp(heads(w_log)))
    y = rwkv7_scan(rh, decay, kh, vh, -kk, kk * ah)

    y = group_norm_heads(y, gn_g.reshape(H, N), gn_b.reshape(H, N), RWKV_GN_EPS)
    bonus = jnp.sum(rh * kh * r_k, -1, keepdims=True) * vh
    y = (y + bonus).reshape(Bsz, S, D).astype(x.dtype)
    return (y * g) @ w_o


def rglru_mixer(x, positions, w_in, conv_w, conv_b, w_ga, b_ga, w_gx, b_gx, lam, w_out):
    Bsz, S, _ = x.shape
    gate, u = jnp.split(x @ w_in, 2, axis=-1)
    u = (causal_dwconv(u, conv_w) + conv_b).astype(jnp.float32)
    ub = u.reshape(Bsz, S, LRU_BLOCKS, LRU_BW)
    r = jax.nn.sigmoid(jnp.einsum('bsgi,gij->bsgj', ub, w_ga).reshape(Bsz, S, D_RNN) + b_ga)
    i = jax.nn.sigmoid(jnp.einsum('bsgi,gij->bsgj', ub, w_gx).reshape(Bsz, S, D_RNN) + b_gx)
    log_a = -LRU_C * r * jax.nn.softplus(-lam)
    reset = (positions == 0)[..., None]
    a = jnp.where(reset, 0.0, jnp.exp(log_a))
    mult = jnp.where(reset, 1.0, jnp.sqrt(-jnp.expm1(2.0 * log_a)))
    h = linear_recurrence(a, mult * (i * u))
    y = jax.nn.gelu(gate) * h.astype(x.dtype)
    return y @ w_out


def retention_mixer(x, positions, w_in, w_o):
    Bsz, S, D = x.shape
    H, DK, DV = RET_HEADS, RET_DK, RET_DV
    NC = S // CHUNK
    q, k, v, g = jnp.split(x @ w_in, [D, 2 * D, 4 * D], axis=-1)
    q = rotary(q.reshape(Bsz, S, H, DK), positions)
    k = rotary(k.reshape(Bsz, S, H, DK), positions) * (DK ** -0.5)
    v = v.astype(jnp.float32).reshape(Bsz, S, H, DV)

    def to_chunks(t):
        return t.reshape(Bsz, NC, CHUNK, H, t.shape[-1]).transpose(1, 0, 3, 2, 4)

    log_g = jnp.log1p(-(2.0 ** (-5.0 - jnp.arange(H, dtype=jnp.float32))))
    idx = jnp.arange(CHUNK, dtype=jnp.float32)
    intra = jnp.exp(jnp.abs(idx[:, None] - idx[None, :]) * log_g[:, None, None])
    q_dec = jnp.exp((idx + 1.0) * log_g[:, None])[..., None]
    k_dec = jnp.exp((CHUNK - 1.0 - idx) * log_g[:, None])[..., None]
    c_dec = jnp.exp(CHUNK * log_g)[:, None, None]

    def step(state, chunk):
        qc, kc, vc = chunk
        scores = jnp.einsum('bhid,bhjd->bhij', qc, kc) * intra
        out = (jnp.einsum('bhij,bhjv->bhiv', scores, vc)
               + jnp.einsum('bhid,bhdv->bhiv', qc * q_dec, state))
        state = state * c_dec + jnp.einsum('bhjd,bhjv->bhdv', kc * k_dec, vc)
        return state, out

    s0 = jnp.zeros((Bsz, H, DK, DV), jnp.float32)
    _, y = lax.scan(step, s0, (to_chunks(q), to_chunks(k), to_chunks(v)))
    y = y.transpose(1, 0, 3, 2, 4).reshape(Bsz, S, H, DV)
    y = head_rms_norm(y, RET_GN_EPS).reshape(Bsz, S, 2 * D).astype(x.dtype)
    return (jax.nn.silu(g) * y) @ w_o


def swiglu(x, w_gu, w_down):
    gt, up = jnp.split(x @ w_gu, 2, axis=-1)
    return (jax.nn.silu(gt) * up) @ w_down


def moe_ffn(x, w_router, w_gu, w_down):
    Bsz, S, D = x.shape
    xt = x.reshape(-1, D)
    logits = (xt @ w_router).astype(jnp.float32)
    top_v, top_i = lax.top_k(logits, TOP_K)
    probs = jax.nn.softmax(top_v, axis=-1)
    gates = jnp.sum(jax.nn.one_hot(top_i, N_EXPERTS, dtype=jnp.float32) * probs[..., None], axis=1)
    gates = gates.astype(x.dtype)
    out = jnp.zeros_like(xt)
    for e in range(N_EXPERTS):
        out = out + gates[:, e:e + 1] * swiglu(xt, w_gu[e], w_down[e])
    return out.reshape(Bsz, S, D)


def setup_inputs(seed: int = 0) -> dict:
    key = jax.random.key(seed)
    keys = jax.random.split(key, 64)
    counter = [0]

    def nxt():
        k = keys[counter[0]]
        counter[0] += 1
        return k

    def nrm(shape, scale):
        return jax.random.normal(nxt(), shape, jnp.float32) * scale

    def unif(shape, lo, hi):
        return jax.random.uniform(nxt(), shape, jnp.float32, lo, hi)

    D = D_MODEL
    inp = {}
    inp["x"] = nrm((BATCH, SEQ, D), 1.0)
    offsets = jax.random.randint(nxt(), (BATCH, 1), 0, 2, dtype=jnp.int32) * SEQ
    inp["positions"] = offsets + jnp.arange(SEQ, dtype=jnp.int32)[None, :]
    inp["ln_mix_g"] = 1.0 + nrm((DEPTH, D), 0.02)
    inp["ln_mix_b"] = nrm((DEPTH, D), 0.02)
    inp["ln_ffn_g"] = 1.0 + nrm((DEPTH, D), 0.02)
    inp["ln_ffn_b"] = nrm((DEPTH, D), 0.02)
    inp["a_w_in"] = nrm((D, 3 * D), D ** -0.5)
    inp["a_conv_w"] = nrm((CONV_A_WIDTH, D), 0.5)
    inp["a_w_out"] = nrm((D, D), BETA * D ** -0.5)
    inp["b_mix"] = unif((RWKV_N_MIX, D), 0.0, 1.0)
    inp["b_w_r"] = nrm((D, D), D ** -0.5)
    inp["b_w_k"] = nrm((D, D), D ** -0.5)
    inp["b_w_v"] = nrm((D, D), D ** -0.5)
    inp["b_w0"] = unif((D,), -6.0, -1.0)
    inp["b_w1"] = nrm((D, RWKV_DECAY_LORA), D ** -0.5)
    inp["b_w2"] = nrm((RWKV_DECAY_LORA, D), 0.5 * RWKV_DECAY_LORA ** -0.5)
    inp["b_a0"] = nrm((D,), 0.5)
    inp["b_a1"] = nrm((D, RWKV_AAA_LORA), D ** -0.5)
    inp["b_a2"] = nrm((RWKV_AAA_LORA, D), RWKV_AAA_LORA ** -0.5)
    inp["b_g1"] = nrm((D, RWKV_GATE_LORA), D ** -0.5)
    inp["b_g2"] = nrm((RWKV_GATE_LORA, D), RWKV_GATE_LORA ** -0.5)
    inp["b_k_k"] = 0.85 + nrm((D,), 0.05)
    inp["b_k_a"] = 1.0 + nrm((D,), 0.05)
    inp["b_r_k"] = nrm((RWKV_HEADS, RWKV_HEAD), 0.1)
    inp["b_gn_g"] = 1.0 + nrm((D,), 0.02)
    inp["b_gn_b"] = nrm((D,), 0.02)
    inp["b_w_o"] = nrm((D, D), BETA * D ** -0.5)
    inp["c_w_in"] = nrm((D, 2 * D_RNN), D ** -0.5)
    inp["c_conv_w"] = nrm((CONV_C_WIDTH, D_RNN), 0.5)
    inp["c_conv_b"] = nrm((D_RNN,), 0.02)
    inp["c_w_ga"] = nrm((LRU_BLOCKS, LRU_BW, LRU_BW), LRU_BW ** -0.5)
    inp["c_b_ga"] = nrm((D_RNN,), 0.02)
    inp["c_w_gx"] = nrm((LRU_BLOCKS, LRU_BW, LRU_BW), LRU_BW ** -0.5)
    inp["c_b_gx"] = nrm((D_RNN,), 0.02)
    a_pow = unif((D_RNN,), 0.9, 0.999) ** (1.0 / LRU_C)
    inp["c_lam"] = jnp.log(a_pow) - jnp.log1p(-a_pow)
    inp["c_w_out"] = nrm((D_RNN, D), BETA * D_RNN ** -0.5)
    inp["d_w_in"] = nrm((D, 6 * D), D ** -0.5)
    inp["d_w_o"] = nrm((2 * D, D), BETA * (2 * D) ** -0.5)
    inp["ffn_w_gu"] = nrm((N_DENSE, D, 2 * D_FF), D ** -0.5)
    inp["ffn_w_down"] = nrm((N_DENSE, D_FF, D), BETA * D_FF ** -0.5)
    inp["moe_w_router"] = nrm((N_MOE, D, N_EXPERTS), D ** -0.5)
    inp["moe_w_gu"] = nrm((N_MOE, N_EXPERTS, D, 2 * D_FF_EXPERT), D ** -0.5)
    inp["moe_w_down"] = nrm((N_MOE, N_EXPERTS, D_FF_EXPERT, D), BETA * D_FF_EXPERT ** -0.5)
    return inp


def reference(x, positions, ln_mix_g, ln_mix_b, ln_ffn_g, ln_ffn_b,
              a_w_in, a_conv_w, a_w_out,
              b_mix, b_w_r, b_w_k, b_w_v, b_w0, b_w1, b_w2, b_a0, b_a1, b_a2,
              b_g1, b_g2, b_k_k, b_k_a, b_r_k, b_gn_g, b_gn_b, b_w_o,
              c_w_in, c_conv_w, c_conv_b, c_w_ga, c_b_ga, c_w_gx, c_b_gx, c_lam, c_w_out,
              d_w_in, d_w_o,
              ffn_w_gu, ffn_w_down, moe_w_router, moe_w_gu, moe_w_down):
    mixers = (
        lambda h: short_conv_mixer(h, a_w_in, a_conv_w, a_w_out),
        lambda h: rwkv7_mixer(h, b_mix, b_w_r, b_w_k, b_w_v, b_w0, b_w1, b_w2, b_a0, b_a1, b_a2,
                              b_g1, b_g2, b_k_k, b_k_a, b_r_k, b_gn_g, b_gn_b, b_w_o),
        lambda h: rglru_mixer(h, positions, c_w_in, c_conv_w, c_conv_b, c_w_ga, c_b_ga,
                              c_w_gx, c_b_gx, c_lam, c_w_out),
        lambda h: retention_mixer(h, positions, d_w_in, d_w_o),
    )
    for i in range(DEPTH):
        x = layer_norm(ALPHA * x + mixers[i % N_MIXERS](x), ln_mix_g[i], ln_mix_b[i])
        j = i // 2
        if i % 2 == 0:
            f = swiglu(x, ffn_w_gu[j], ffn_w_down[j])
        else:
            f = moe_ffn(x, moe_w_router[j], moe_w_gu[j], moe_w_down[j])
        x = layer_norm(ALPHA * x + f, ln_ffn_g[i], ln_ffn_b[i])
    return x
```

```cpp
#include <hip/hip_runtime.h>
#include <cstdio>
#include <cstdint>

#ifndef MK_ONE_LAUNCH
#define MK_ONE_LAUNCH 0
#endif

#define LAS __attribute__((address_space(3)))
typedef unsigned short bf16_t;
typedef short bf16x8 __attribute__((ext_vector_type(8)));
typedef float f32x4 __attribute__((ext_vector_type(4)));
typedef float f32x2 __attribute__((ext_vector_type(2)));
typedef unsigned u32x4 __attribute__((ext_vector_type(4)));
typedef unsigned u32x2 __attribute__((ext_vector_type(2)));

#define XB_TMO      128
#define XB_XCNT(j)  (256  + 64 * (j))
#define XB_XSUB(j)  (1280 + 64 * (j))
#define XB_XGEN(j)  (2304 + 64 * (j))
#define XB_TOP      3328
#define XB_TOPGEN   3392
#define XCD_BAR_WORDS 3456
#define XB_SPIN_CAP (1u << 18)

__device__ __forceinline__ unsigned xb_ld(unsigned* p)              { return __hip_atomic_load(p, __ATOMIC_RELAXED, __HIP_MEMORY_SCOPE_AGENT); }
__device__ __forceinline__ unsigned xb_add(unsigned* p, unsigned v) { return __hip_atomic_fetch_add(p, v, __ATOMIC_RELAXED, __HIP_MEMORY_SCOPE_AGENT); }
__device__ __forceinline__ unsigned xb_xcc_id() { return (unsigned)__builtin_amdgcn_s_getreg((3 << 11) | 20) & 0xFu; }
#define XB_SPIN(cond, bar) do { unsigned _sp = 0; while (cond) { __builtin_amdgcn_s_sleep(1); \
    if ((++_sp & 255u) == 0u) { if (xb_ld(&(bar)[XB_TMO])) break; if (_sp > XB_SPIN_CAP) { atomicAdd(&(bar)[XB_TMO], 1u); break; } } } } while (0)

struct XcdBarrier { unsigned* bar; unsigned x; volatile LAS unsigned* st; };

__device__ __forceinline__ XcdBarrier xcd_barrier_post(unsigned* bar, volatile LAS unsigned* st) {
    XcdBarrier b; b.bar = bar; b.x = xb_xcc_id(); b.st = st;
    if (threadIdx.x == 0) (void)xb_add(&bar[XB_XCNT(b.x)], 1u);
    return b;
}
__device__ __forceinline__ void xcd_barrier_complete(unsigned* bar, unsigned x, unsigned& nloc, unsigned& nx) {
    const unsigned G = gridDim.x * gridDim.y * gridDim.z;
    unsigned sum, cnt, mine, sp = 0u;
    for (;;) {
        sum = 0u; cnt = 0u; mine = 0u;
#pragma unroll
        for (unsigned j = 0; j < 16; ++j) { const unsigned c = xb_ld(&bar[XB_XCNT(j)]); sum += c; cnt += (c > 0u) ? 1u : 0u; mine = (j == x) ? c : mine; }
        if (sum == G) break;
        __builtin_amdgcn_s_sleep(1);
        if ((++sp & 255u) == 0u) { if (xb_ld(&bar[XB_TMO])) break; if (sp > XB_SPIN_CAP) { atomicAdd(&bar[XB_TMO], 1u); break; } }
    }
    nloc = mine > 0u ? mine : 1u; nx = cnt > 0u ? cnt : 1u;
}
__device__ __forceinline__ void xcd_barrier(const XcdBarrier& b) {
    asm volatile("s_waitcnt vmcnt(0)" ::: "memory");
    __syncthreads();
    if (threadIdx.x == 0) {
        unsigned* bar = b.bar;
        __builtin_amdgcn_s_waitcnt(0);
        unsigned nloc = b.st[0], nx = b.st[1];
        if (nloc == 0u) { xcd_barrier_complete(bar, b.x, nloc, nx); b.st[0] = nloc; b.st[1] = nx; }
        const unsigned old = xb_add(&bar[XB_XSUB(b.x)], 1u);
        const unsigned gen = old / nloc;
        if (old + 1u == (gen + 1u) * nloc) {
            __builtin_amdgcn_fence(__ATOMIC_RELEASE, "agent");
            asm volatile("s_waitcnt vmcnt(0)" ::: "memory");
            const unsigned og = xb_add(&bar[XB_TOP], 1u);
            const unsigned tg = og / nx;
            if (og + 1u == (tg + 1u) * nx) xb_add(&bar[XB_TOPGEN], 1u);
            else XB_SPIN(xb_ld(&bar[XB_TOPGEN]) == tg, bar);
            __builtin_amdgcn_fence(__ATOMIC_ACQUIRE, "agent");
            xb_add(&bar[XB_XGEN(b.x)], 1u);
            asm volatile("s_waitcnt vmcnt(0)" ::: "memory");
        } else {
            XB_SPIN(xb_ld(&bar[XB_XGEN(b.x)]) == gen, bar);
            __builtin_amdgcn_fence(__ATOMIC_ACQUIRE, "agent");
            asm volatile("s_waitcnt vmcnt(0)" ::: "memory");
        }
    }
    __syncthreads();
}

constexpr int T_ = 16384, D_ = 1024, S_ = 2048;
constexpr int DFF = 2816, DFE = 3584, DRNN = 1280;
constexpr int NSLOT = 34816;
constexpr float ALPHA = 1.6817928305074290f;
constexpr float LN_EPS = 1e-5f;
constexpr int NTHREADS = 512;
constexpr int STAGE_BYTES = 131072;
constexpr int MISC_OFF = STAGE_BYTES;
constexpr int MISC_BYTES = 8192;
constexpr int LDS_BYTES = STAGE_BYTES + MISC_BYTES;

constexpr size_t al256(size_t x) { return (x + 255) & ~(size_t)255; }
constexpr size_t OFF_CTL = 0, CTL_BYTES = 65536;
constexpr size_t OFF_WA_IN  = OFF_CTL + CTL_BYTES;
constexpr size_t OFF_WA_OUT = OFF_WA_IN  + (size_t)3072 * 1024 * 2;
constexpr size_t OFF_WB_RKV = OFF_WA_OUT + (size_t)1024 * 1024 * 2;
constexpr size_t OFF_WB_L1  = OFF_WB_RKV + (size_t)3 * 1024 * 1024 * 2;
constexpr size_t OFF_WB_L2  = OFF_WB_L1  + (size_t)3 * 256 * 1024 * 2;
constexpr size_t OFF_WB_O   = OFF_WB_L2  + (size_t)3 * 1024 * 256 * 2;
constexpr size_t OFF_WC_IN  = OFF_WB_O   + (size_t)1024 * 1024 * 2;
constexpr size_t OFF_WC_G   = OFF_WC_IN  + (size_t)2560 * 1024 * 2;
constexpr size_t OFF_WC_OUT = OFF_WC_G   + (size_t)5 * 512 * 256 * 2;
constexpr size_t OFF_WD_IN  = OFF_WC_OUT + (size_t)1024 * 1280 * 2;
constexpr size_t OFF_WD_O   = OFF_WD_IN  + (size_t)6144 * 1024 * 2;
constexpr size_t OFF_WF_GU  = OFF_WD_O   + (size_t)1024 * 2048 * 2;
constexpr size_t OFF_WF_DN  = OFF_WF_GU  + (size_t)2 * 5632 * 1024 * 2;
constexpr size_t OFF_WM_GU  = OFF_WF_DN  + (size_t)2 * 1024 * 2816 * 2;
constexpr size_t OFF_WM_DN  = OFF_WM_GU  + (size_t)16 * 7168 * 1024 * 2;
constexpr size_t OFF_ROT    = OFF_WM_DN  + (size_t)16 * 1024 * 3584 * 2;
constexpr size_t OFF_X      = OFF_ROT    + (size_t)2 * T_ * 128 * 4;
constexpr size_t OFF_XB     = OFF_X      + (size_t)T_ * D_ * 4;
constexpr size_t OFF_PRE    = OFF_XB     + (size_t)T_ * D_ * 2;
constexpr size_t OFF_ROUTE  = OFF_PRE    + (size_t)T_ * D_ * 4;
constexpr size_t OFF_ARENA  = OFF_ROUTE  + (size_t)T_ * 8 * 4;
constexpr size_t A0_BCV = OFF_ARENA;
constexpr size_t A0_YA  = A0_BCV + (size_t)T_ * 3072 * 2;
constexpr size_t AF_H   = OFF_ARENA;
constexpr size_t A1_XMIX = OFF_ARENA;
constexpr size_t A1_RKV  = A1_XMIX + (size_t)6 * T_ * D_ * 2;
constexpr size_t A1_L1   = A1_RKV  + (size_t)3 * T_ * D_ * 2;
constexpr size_t A1_O3   = A1_L1   + (size_t)3 * T_ * 256 * 2;
constexpr size_t A1_Y    = A1_O3   + (size_t)3 * T_ * D_ * 4;
constexpr size_t A1_YB   = A1_Y    + (size_t)T_ * D_ * 4;
constexpr size_t A1_END  = A1_YB   + (size_t)T_ * D_ * 2;
constexpr size_t AM_XG = OFF_ARENA;
constexpr size_t AM_H  = AM_XG + (size_t)NSLOT * D_ * 2;
constexpr size_t AM_O  = AM_H  + (size_t)NSLOT * DFE * 2;
constexpr size_t A2_GG = OFF_ARENA;
constexpr size_t A2_UU = A2_GG + (size_t)T_ * DRNN * 2;
constexpr size_t A2_UC = A2_UU + (size_t)T_ * DRNN * 2;
constexpr size_t A2_AT = A2_UC + (size_t)T_ * DRNN * 2;
constexpr size_t A2_BT = A2_AT + (size_t)T_ * DRNN * 4;
constexpr size_t A2_YC = A2_BT + (size_t)T_ * DRNN * 4;
constexpr size_t A3_QR = OFF_ARENA;
constexpr size_t A3_KR = A3_QR + (size_t)T_ * D_ * 2;
constexpr size_t A3_GS = A3_KR + (size_t)T_ * D_ * 2;
constexpr size_t A3_VT = A3_GS + (size_t)T_ * 2048 * 2;
constexpr size_t A3_SC = A3_VT + (size_t)T_ * 2048 * 2;
constexpr size_t A3_Y  = A3_SC + (size_t)32 * 2048 * 2048 * 2;
constexpr size_t A3_YD = A3_Y  + (size_t)T_ * 2048 * 2;
constexpr size_t A3_END = A3_YD + (size_t)T_ * 2048 * 2;
constexpr size_t WS_NEED = (A1_END > A3_END ? A1_END : A3_END);
constexpr int CTL_MOE_CNT = 4096;

__device__ __forceinline__ int rfl(int v) { return __builtin_amdgcn_readfirstlane(v); }
__device__ __forceinline__ const char* rfl_ptr(const char* p) {
    const unsigned long long v = (unsigned long long)p;
    const unsigned lo = (unsigned)rfl((int)(unsigned)v), hi = (unsigned)rfl((int)(unsigned)(v >> 32));
    return (const char*)(((unsigned long long)hi << 32) | lo);
}
__device__ __forceinline__ unsigned pk_bf16(float lo, float hi) { unsigned r; asm volatile("v_cvt_pk_bf16_f32 %0, %1, %2" : "=v"(r) : "v"(lo), "v"(hi)); return r; }
__device__ __forceinline__ float bf_lo(unsigned w) { return __uint_as_float(w << 16); }
__device__ __forceinline__ float bf_hi(unsigned w) { return __uint_as_float(w & 0xffff0000u); }
__device__ __forceinline__ float bf1(bf16_t h) { return __uint_as_float(((unsigned)h) << 16); }
__device__ __forceinline__ float fsigmoid(float x) { return __builtin_amdgcn_rcpf(1.0f + __expf(-x)); }
__device__ __forceinline__ float fsilu(float x) { return x * fsigmoid(x); }
__device__ __forceinline__ float ftanh(float x) { const float t = __expf(2.0f * x); return 1.0f - 2.0f * __builtin_amdgcn_rcpf(t + 1.0f); }
__device__ __forceinline__ float fgelu_tanh(float x) { const float u = 0.7978845608028654f * (x + 0.044715f * x * x * x); return 0.5f * x * (1.0f + ftanh(u)); }
__device__ __forceinline__ float wave_sum(float v) {
#pragma unroll
    for (int o = 32; o >= 1; o >>= 1) v += __shfl_xor(v, o);
    return v;
}
template <int CTRL> __device__ __forceinline__ float dpp_mov(float x) { return __int_as_float(__builtin_amdgcn_update_dpp(0, __float_as_int(x), CTRL, 0xf, 0xf, true)); }
__device__ __forceinline__ float allreduce16(float x) {
    x += dpp_mov<0xB1>(x);
    x += dpp_mov<0x4E>(x);
    x += dpp_mov<0x141>(x);
    x += dpp_mov<0x140>(x);
    return x;
}

namespace pg8 {
constexpr int BM = 256, BK = 64, HALF = 128, HTB = HALF * BK * 2;
__device__ __forceinline__ int lds_byte(int r, int c) { const int st = (r >> 4) * 2 + (c >> 5), rr = r & 15, cc = c & 31, ob = rr * 64 + cc * 2; return st * 1024 + (ob ^ (((ob >> 9) & 1) << 5)); }
__device__ __forceinline__ void stage_rc(int b, int& R, int& C) { const int st = b / 1024, sb = b % 1024, swz = sb ^ (((sb >> 9) & 1) << 5); R = (st >> 1) * 16 + swz / 64; C = (st & 1) * 32 + (swz % 64) / 2; }
__device__ __forceinline__ int perm32(int rho) { const int n = rho >> 4, i = rho & 15; return 8 * (i >> 2) + 4 * n + (i & 3); }

struct Unit { const char* a; const char* b; int nt; int pm, pn, job, ro; };

template <class Epi, class Sched>
__device__ __forceinline__ void gemm_phase(LAS unsigned char* lds, const int lda, const int ldb, const Sched& S, const Epi& E) {
    const int tid = threadIdx.x, wid = rfl(tid >> 6), lane = tid & 63, wr = wid >> 2, wc = wid & 3, fr = lane & 15, fq = lane >> 4;
    unsigned voffA[2], voffB[2];
#pragma unroll
    for (int i = 0; i < 2; ++i) { int R, C; stage_rc(tid * 16 + i * 8192, R, C); const int Rb = (R & ~31) + perm32(R & 31);
        voffA[i] = (unsigned)(R * lda + C) * 2u; voffB[i] = (unsigned)(Rb * ldb + C) * 2u; }
    const size_t kstep = (size_t)(BK * 2);
    const size_t hstepA = (size_t)HALF * lda * 2, hstepB = (size_t)HALF * ldb * 2;
    const unsigned ldsw = (unsigned)wid * 1024u;
    const int aoff = lds_byte(wr * 64 + fr, fq * 8), boff = lds_byte(wc * 32 + fr, fq * 8);
#define PG8_SA(b, h) (((b) * 2 + (h)) * HTB)
#define PG8_SB(b, h) ((4 + (b) * 2 + (h)) * HTB)
#define PG8_STAGE(bufoff, gbase, voff) do { _Pragma("unroll") for (int _i = 0; _i < 2; ++_i) \
        __builtin_amdgcn_global_load_lds((const unsigned*)((const char*)(gbase) + (voff)[_i]), (LAS unsigned*)(lds + (bufoff) + ldsw + _i * 8192), 16, 0, 0); } while (0)
#define PG8_LDA(dst, b, h) do { _Pragma("unroll") for (int m = 0; m < 4; ++m) _Pragma("unroll") for (int k = 0; k < 2; ++k) dst[m][k] = *(const LAS bf16x8*)(lds + PG8_SA(b, h) + aoff + m * 2048 + k * 1024); } while (0)
#define PG8_LDB(dst, b, h) do { _Pragma("unroll") for (int n = 0; n < 2; ++n) _Pragma("unroll") for (int k = 0; k < 2; ++k) dst[n][k] = *(const LAS bf16x8*)(lds + PG8_SB(b, h) + boff + n * 2048 + k * 1024); } while (0)
#define PG8_MMA(ai, bj, At, Bt) do { __builtin_amdgcn_s_setprio(1); _Pragma("unroll") for (int m = 0; m < 4; ++m) _Pragma("unroll") for (int n = 0; n < 2; ++n) _Pragma("unroll") for (int k = 0; k < 2; ++k) \
        acc[ai][bj][m][n] = __builtin_amdgcn_mfma_f32_16x16x32_bf16(Bt[n][k], At[m][k], acc[ai][bj][m][n], 0, 0, 0); __builtin_amdgcn_s_setprio(0); } while (0)
#define PG8_WAIT_V(n) asm volatile("s_waitcnt vmcnt(" #n ")" ::: "memory")
#define PG8_WAIT_L(n) asm volatile("s_waitcnt lgkmcnt(" #n ")" ::: "memory")
#define PG8_BAR __builtin_amdgcn_s_barrier()
#define PG8_SCHED __builtin_amdgcn_sched_barrier(0)
    Unit cur, nxt; int ui = 0;
    if (!S.next(0, cur)) return;
    f32x4 acc[2][2][4][2];
#pragma unroll
    for (int a = 0; a < 2; ++a)
#pragma unroll
        for (int b = 0; b < 2; ++b)
#pragma unroll
            for (int m = 0; m < 4; ++m)
#pragma unroll
                for (int n = 0; n < 2; ++n) acc[a][b][m][n] = (f32x4){0.f, 0.f, 0.f, 0.f};
    bf16x8 At[4][2], B0[2][2], B1[2][2];
    const char* cA = cur.a; const char* cB = cur.b;
    PG8_STAGE(PG8_SB(0, 0), cB, voffB); PG8_STAGE(PG8_SA(0, 0), cA, voffA); PG8_STAGE(PG8_SB(0, 1), cB + hstepB, voffB); PG8_STAGE(PG8_SA(0, 1), cA + hstepA, voffA);
    if (wr == 1) PG8_BAR;
    PG8_WAIT_V(4); PG8_BAR;
    PG8_STAGE(PG8_SB(1, 0), cB + kstep, voffB); PG8_STAGE(PG8_SA(1, 0), cA + kstep, voffA); PG8_STAGE(PG8_SB(1, 1), cB + hstepB + kstep, voffB);
    PG8_WAIT_V(6); PG8_BAR;
    for (;;) {
        const bool has_next = S.next(ui + 1, nxt);
        const char* nA = has_next ? nxt.a : cA; const char* nB = has_next ? nxt.b : cB;
        const int nt = cur.nt;
        for (int t = 0; t < nt; t += 2) {
            const bool last = (t == nt - 2);
            const char* a1 = cA + (size_t)(t + 1) * kstep;
            const char* a2 = last ? nA : cA + (size_t)(t + 2) * kstep; const char* b2 = last ? nB : cB + (size_t)(t + 2) * kstep;
            const char* a3 = a2 + kstep; const char* b3 = b2 + kstep;
            PG8_LDB(B0, 0, 0); PG8_SCHED; PG8_LDA(At, 0, 0); PG8_STAGE(PG8_SA(1, 1), a1 + hstepA, voffA);
            PG8_WAIT_L(8); PG8_BAR; PG8_WAIT_L(0); PG8_MMA(0, 0, At, B0); PG8_BAR; PG8_SCHED;
            PG8_LDB(B1, 0, 1); PG8_STAGE(PG8_SB(0, 0), b2, voffB);
            PG8_BAR; PG8_WAIT_L(0); PG8_MMA(0, 1, At, B1); PG8_BAR;
            PG8_LDA(At, 0, 1); PG8_STAGE(PG8_SA(0, 0), a2, voffA);
            PG8_BAR; PG8_WAIT_L(0); PG8_MMA(1, 0, At, B0); PG8_BAR; PG8_SCHED;
            PG8_STAGE(PG8_SB(0, 1), b2 + hstepB, voffB);
            PG8_WAIT_V(6); PG8_BAR; PG8_MMA(1, 1, At, B1); PG8_BAR;
            PG8_LDB(B0, 1, 0); PG8_SCHED; PG8_LDA(At, 1, 0); PG8_STAGE(PG8_SA(0, 1), a2 + hstepA, voffA);
            PG8_WAIT_L(8); PG8_BAR; PG8_WAIT_L(0); PG8_MMA(0, 0, At, B0); PG8_BAR; PG8_SCHED;
            PG8_LDB(B1, 1, 1); PG8_STAGE(PG8_SB(1, 0), b3, voffB);
            PG8_BAR; PG8_WAIT_L(0); PG8_MMA(0, 1, At, B1); PG8_BAR;
            PG8_LDA(At, 1, 1); PG8_STAGE(PG8_SA(1, 0), a3, voffA);
            PG8_BAR; PG8_WAIT_L(0); PG8_MMA(1, 0, At, B0); PG8_BAR; PG8_SCHED;
            PG8_STAGE(PG8_SB(1, 1), b3 + hstepB, voffB);
            PG8_WAIT_V(6); PG8_BAR; PG8_MMA(1, 1, At, B1); PG8_BAR;
        }
#pragma unroll
        for (int ai = 0; ai < 2; ++ai)
#pragma unroll
            for (int m = 0; m < 4; ++m) E(cur, ai * HALF + wr * 64 + m * 16 + fr, wc * 32 + 8 * fq, acc[ai][0][m][0], acc[ai][0][m][1], acc[ai][1][m][0], acc[ai][1][m][1]);
        if (!has_next) break;
#pragma unroll
        for (int a = 0; a < 2; ++a)
#pragma unroll
            for (int b = 0; b < 2; ++b)
#pragma unroll
                for (int m = 0; m < 4; ++m)
#pragma unroll
                    for (int n = 0; n < 2; ++n) acc[a][b][m][n] = (f32x4){0.f, 0.f, 0.f, 0.f};
        cur = nxt; cA = nA; cB = nB; ++ui;
    }
    PG8_WAIT_V(0);
    if (wr == 0) PG8_BAR;
    PG8_BAR;
#undef PG8_SA
#undef PG8_SB
#undef PG8_STAGE
#undef PG8_LDA
#undef PG8_LDB
#undef PG8_MMA
#undef PG8_WAIT_V
#undef PG8_WAIT_L
#undef PG8_BAR
#undef PG8_SCHED
}

__device__ __forceinline__ void tile_map(int L, int nM, int nN, int& pm, int& pn) {
    const int nwg = nM * nN, q = nwg / 8, r = nwg % 8, xcd = L % 8, off = L / 8;
    const int wgid = (xcd < r ? xcd * (q + 1) : r * (q + 1) + (xcd - r) * q) + off;
    const int nig = 8 * nN, gid = wgid / nig, fm = gid * 8, gsz = (nM - fm) < 8 ? (nM - fm) : 8;
    pm = fm + ((wgid % nig) % gsz); pn = (wgid % nig) / gsz;
}

constexpr int JOBW = 10;
struct JobSched {
    const LAS int* tab; int nj, total, G, c, lda, ldb;
    __device__ __forceinline__ bool next(int i, Unit& u) const {
        const long Lg = (long)i * G + c; if (Lg >= total) return false;
        const int L = (int)Lg; int j = 0;
        while (j + 1 < nj && L >= tab[(j + 1) * JOBW + 7]) ++j;
        const LAS int* J = tab + j * JOBW;
        const unsigned long long ja = ((unsigned long long)(unsigned)J[1] << 32) | (unsigned)J[0], jb = ((unsigned long long)(unsigned)J[3] << 32) | (unsigned)J[2];
        int pm, pn; tile_map(L - J[7], J[4], J[5], pm, pn);
        pm = rfl(pm); pn = rfl(pn);
        u.a = rfl_ptr((const char*)ja + (size_t)pm * 256 * lda * 2);
        u.b = rfl_ptr((const char*)jb + (size_t)pn * 256 * ldb * 2);
        u.nt = rfl(J[6]); u.pm = pm; u.pn = pn; u.job = rfl(j); u.ro = rfl(J[8]);
        return true;
    }
};
}
using pg8::Unit;

struct Params { const float* in[43]; float* out; unsigned char* ws; int ph_lo, ph_hi; };

struct Ctx {
    const Params* p; unsigned char* ws; LAS unsigned char* lds; int tid, lane, wave, G, bid;
    __device__ __forceinline__ const float* in(int i) const { return p->in[i]; }
    template <class Tp> __device__ __forceinline__ Tp* w(size_t off) const { return (Tp*)(ws + off); }
};

__device__ __forceinline__ void store8_bf16(bf16_t* p, const f32x4& a, const f32x4& b) {
    u32x4 w; w.x = pk_bf16(a[0], a[1]); w.y = pk_bf16(a[2], a[3]); w.z = pk_bf16(b[0], b[1]); w.w = pk_bf16(b[2], b[3]);
    *(u32x4*)p = w;
}

__device__ __forceinline__ void set_job(const Ctx& X, int j, const void* a, const void* b, int nM, int nN, int nt, int base, int ro) {
    LAS int* J = (LAS int*)(X.lds + MISC_OFF + 64) + j * pg8::JOBW;
    const unsigned long long ua = (unsigned long long)a, ub = (unsigned long long)b;
    J[0] = (int)(unsigned)ua; J[1] = (int)(unsigned)(ua >> 32); J[2] = (int)(unsigned)ub; J[3] = (int)(unsigned)(ub >> 32);
    J[4] = nM; J[5] = nN; J[6] = nt; J[7] = base; J[8] = ro; J[9] = 0;
}
__device__ __forceinline__ pg8::JobSched make_sched(const Ctx& X, int nj, int total, int lda, int ldb) {
    pg8::JobSched S; S.tab = (const LAS int*)(X.lds + MISC_OFF + 64); S.nj = nj; S.total = total; S.G = X.G; S.c = X.bid; S.lda = lda; S.ldb = ldb; return S;
}

struct EpiStoreBf16 {
    bf16_t* O; int ldo;
    __device__ __forceinline__ void operator()(const Unit& u, int r, int c, const f32x4& l0, const f32x4& l1, const f32x4& h0, const f32x4& h1) const {
        bf16_t* q = O + (size_t)(u.ro + u.pm * 256 + r) * ldo + u.pn * 256 + c;
        store8_bf16(q, l0, l1); store8_bf16(q + 128, h0, h1);
    }
};
struct EpiResid {
    const float* x; float* pre;
    __device__ __forceinline__ void operator()(const Unit& u, int r, int c, const f32x4& l0, const f32x4& l1, const f32x4& h0, const f32x4& h1) const {
        const size_t o = (size_t)(u.pm * 256 + r) * D_ + u.pn * 256 + c;
        const f32x4 x0 = *(const f32x4*)(x + o), x1 = *(const f32x4*)(x + o + 4), x2 = *(const f32x4*)(x + o + 128), x3 = *(const f32x4*)(x + o + 132);
        *(f32x4*)(pre + o) = x0 * ALPHA + l0; *(f32x4*)(pre + o + 4) = x1 * ALPHA + l1;
        *(f32x4*)(pre + o + 128) = x2 * ALPHA + h0; *(f32x4*)(pre + o + 132) = x3 * ALPHA + h1;
    }
};
struct EpiSwiglu {
    bf16_t* H; int ldh;
    __device__ __forceinline__ void operator()(const Unit& u, int r, int c, const f32x4& l0, const f32x4& l1, const f32x4& h0, const f32x4& h1) const {
        f32x4 a, b;
#pragma unroll
        for (int j = 0; j < 4; ++j) { a[j] = fsilu(l0[j]) * h0[j]; b[j] = fsilu(l1[j]) * h1[j]; }
        store8_bf16(H + (size_t)(u.ro + u.pm * 256 + r) * ldh + u.pn * 128 + c, a, b);
    }
};
struct EpiRwkv1 {
    bf16_t* rkv; bf16_t* l1;
    __device__ __forceinline__ void operator()(const Unit& u, int r, int c, const f32x4& l0, const f32x4& l1v, const f32x4& h0, const f32x4& h1) const {
        const int row = u.pm * 256 + r;
        if (u.job < 3) { bf16_t* q = rkv + (size_t)u.job * T_ * D_ + (size_t)row * D_ + u.pn * 256 + c; store8_bf16(q, l0, l1v); store8_bf16(q + 128, h0, h1); }
        else {
            f32x4 a = l0, b = l1v, cc = h0, d = h1;
            if (u.job == 3) {
#pragma unroll
                for (int j = 0; j < 4; ++j) { a[j] = ftanh(a[j]); b[j] = ftanh(b[j]); cc[j] = ftanh(cc[j]); d[j] = ftanh(d[j]); } }
            else if (u.job == 5) {
#pragma unroll
                for (int j = 0; j < 4; ++j) { a[j] = fsigmoid(a[j]); b[j] = fsigmoid(b[j]); cc[j] = fsigmoid(cc[j]); d[j] = fsigmoid(d[j]); } }
            bf16_t* q = l1 + (size_t)(u.job - 3) * T_ * 256 + (size_t)row * 256 + c; store8_bf16(q, a, b); store8_bf16(q + 128, cc, d);
        }
    }
};
struct EpiRwkv2 {
    float* o3; const float* w0; const float* a0;
    __device__ __forceinline__ void one(const Unit& u, float* q, int col, const f32x4& v) const {
        f32x4 o;
        if (u.job == 0) { const f32x4 bv = *(const f32x4*)(w0 + col);
#pragma unroll
            for (int j = 0; j < 4; ++j) o[j] = __expf(-0.6065306597126334f * fsigmoid(bv[j] + v[j])); }
        else if (u.job == 1) { const f32x4 bv = *(const f32x4*)(a0 + col);
#pragma unroll
            for (int j = 0; j < 4; ++j) o[j] = fsigmoid(bv[j] + v[j]); }
        else o = v;
        *(f32x4*)q = o;
    }
    __device__ __forceinline__ void operator()(const Unit& u, int r, int c, const f32x4& l0, const f32x4& l1, const f32x4& h0, const f32x4& h1) const {
        const int col = u.pn * 256 + c; float* q = o3 + (size_t)u.job * T_ * D_ + (size_t)(u.pm * 256 + r) * D_ + col;
        one(u, q, col, l0); one(u, q + 4, col + 4, l1); one(u, q + 128, col + 128, h0); one(u, q + 132, col + 132, h1);
    }
};
struct EpiGriffinIn {
    bf16_t* gg; bf16_t* uu;
    __device__ __forceinline__ void operator()(const Unit& u, int r, int c, const f32x4& l0, const f32x4& l1, const f32x4& h0, const f32x4& h1) const {
        const int row = u.pm * 256 + r;
        if (u.pn < 5) { f32x4 a, b, cc, d;
#pragma unroll
            for (int j = 0; j < 4; ++j) { a[j] = fgelu_tanh(l0[j]); b[j] = fgelu_tanh(l1[j]); cc[j] = fgelu_tanh(h0[j]); d[j] = fgelu_tanh(h1[j]); }
            bf16_t* q = gg + (size_t)row * DRNN + u.pn * 256 + c; store8_bf16(q, a, b); store8_bf16(q + 128, cc, d); }
        else { bf16_t* q = uu + (size_t)row * DRNN + (u.pn - 5) * 256 + c; store8_bf16(q, l0, l1); store8_bf16(q + 128, h0, h1); }
    }
};
struct EpiGates {
    const bf16_t* uc; const float* b_ga; const float* b_gx; const float* lam; const int* pos; float* at; float* bt;
    __device__ __forceinline__ void four(int row, int ch, bool reset, const f32x4& lo, const f32x4& hi) const {
        const f32x4 ba = *(const f32x4*)(b_ga + ch), bx = *(const f32x4*)(b_gx + ch), lm = *(const f32x4*)(lam + ch);
        const u32x2 uw = *(const u32x2*)(uc + (size_t)row * DRNN + ch);
        const float uv[4] = {bf_lo(uw.x), bf_hi(uw.x), bf_lo(uw.y), bf_hi(uw.y)};
        f32x4 a, b;
#pragma unroll
        for (int j = 0; j < 4; ++j) {
            const float rg = fsigmoid(lo[j] + ba[j]), ig = fsigmoid(hi[j] + bx[j]);
            const float sp = log1pf(__expf(-lm[j]));
            const float la = -8.0f * rg * sp;
            float av = __expf(la), mult = sqrtf(-expm1f(2.0f * la));
            if (reset) { av = 0.f; mult = 1.f; }
            a[j] = av; b[j] = mult * (ig * uv[j]);
        }
        *(f32x4*)(at + (size_t)row * DRNN + ch) = a; *(f32x4*)(bt + (size_t)row * DRNN + ch) = b;
    }
    __device__ __forceinline__ void operator()(const Unit& u, int r, int c, const f32x4& l0, const f32x4& l1, const f32x4& h0, const f32x4& h1) const {
        const int row = u.pm * 256 + r, ch = u.job * 256 + u.pn * 128 + c; const bool reset = pos[row] == 0;
        four(row, ch, reset, l0, h0); four(row, ch + 4, reset, l1, h1);
    }
};
struct EpiRetIn {
    bf16_t* qr; bf16_t* kr; bf16_t* gs; bf16_t* vt; const float* rc; const float* rs;
    __device__ __forceinline__ void operator()(const Unit& u, int r, int c, const f32x4& l0, const f32x4& l1, const f32x4& h0, const f32x4& h1) const {
        const int row = u.pm * 256 + r;
        if (u.job < 2) {
            const f32x4 c0 = *(const f32x4*)(rc + (size_t)row * 128 + c), c1 = *(const f32x4*)(rc + (size_t)row * 128 + c + 4);
            const f32x4 s0 = *(const f32x4*)(rs + (size_t)row * 128 + c), s1 = *(const f32x4*)(rs + (size_t)row * 128 + c + 4);
            const float sc = u.job == 1 ? 0.0625f : 1.0f;
            const f32x4 a = (l0 * c0 - h0 * s0) * sc, b = (l1 * c1 - h1 * s1) * sc, cc = (l0 * s0 + h0 * c0) * sc, d = (l1 * s1 + h1 * c1) * sc;
            bf16_t* q = (u.job == 0 ? qr : kr) + (size_t)row * D_ + u.pn * 256 + c; store8_bf16(q, a, b); store8_bf16(q + 128, cc, d);
        } else if (u.job == 2) {
            f32x4 a, b, cc, d;
#pragma unroll
            for (int j = 0; j < 4; ++j) { a[j] = fsilu(l0[j]); b[j] = fsilu(l1[j]); cc[j] = fsilu(h0[j]); d[j] = fsilu(h1[j]); }
            bf16_t* q = gs + (size_t)row * 2048 + u.pn * 256 + c; store8_bf16(q, a, b); store8_bf16(q + 128, cc, d);
        } else { bf16_t* q = vt + (size_t)row * T_ + u.pn * 256 + c; store8_bf16(q, l0, l1); store8_bf16(q + 128, h0, h1); }
    }
};
struct EpiScores {
    bf16_t* sc;
    __device__ __forceinline__ f32x4 four(int i, int j0, float l2g, const f32x4& v) const {
        f32x4 o;
#pragma unroll
        for (int jj = 0; jj < 4; ++jj) { const int j = j0 + jj; const int d = i > j ? i - j : j - i;
            const float w = ((i >> 6) >= (j >> 6)) ? exp2f((float)d * l2g) : 0.f; o[jj] = v[jj] * w; }
        return o;
    }
    __device__ __forceinline__ void operator()(const Unit& u, int r, int c, const f32x4& l0, const f32x4& l1, const f32x4& h0, const f32x4& h1) const {
        const int h = u.job & 3, i = u.pm * 256 + r, j0 = u.pn * 256 + c;
        const float l2g = __log2f(1.0f - exp2f(-5.0f - (float)h));
        const f32x4 a = four(i, j0, l2g, l0), b = four(i, j0 + 4, l2g, l1), cc = four(i, j0 + 128, l2g, h0), d = four(i, j0 + 132, l2g, h1);
        bf16_t* q = sc + (size_t)u.job * 2048 * 2048 + (size_t)i * 2048 + j0; store8_bf16(q, a, b); store8_bf16(q + 128, cc, d);
    }
};
struct EpiRetOut {
    bf16_t* y;
    __device__ __forceinline__ void operator()(const Unit& u, int r, int c, const f32x4& l0, const f32x4& l1, const f32x4& h0, const f32x4& h1) const {
        const int b = u.job >> 2, h = u.job & 3;
        bf16_t* q = y + (size_t)(b * 2048 + u.pm * 256 + r) * 2048 + h * 512 + u.pn * 256 + c; store8_bf16(q, l0, l1); store8_bf16(q + 128, h0, h1);
    }
};
struct ScoreSched {
    const char* qr; const char* kr; int G, c;
    __device__ __forceinline__ bool next(int i, Unit& u) const {
        const long Lg = (long)i * G + c; if (Lg >= 32 * 36) return false;
        const int L = (int)Lg, bh = L / 36; int tri = L % 36, pm = 0; while (tri >= pm + 1) { tri -= pm + 1; ++pm; }
        const int b = bh >> 2, h = bh & 3;
        u.a = qr + ((size_t)(b * 2048 + pm * 256) * D_ + h * 256) * 2; u.b = kr + ((size_t)(b * 2048 + tri * 256) * D_ + h * 256) * 2;
        u.nt = 4; u.pm = pm; u.pn = tri; u.job = bh; u.ro = 0; return true;
    }
};
struct RetOutSched {
    const char* sc; const char* vt; int G, c;
    __device__ __forceinline__ bool next(int i, Unit& u) const {
        const long Lg = (long)i * G + c; if (Lg >= 512) return false;
        const int L = (int)Lg, round = L / 256, cc = L % 256, bh = cc / 8, pn = (cc / 4) % 2, pp = cc % 4, pm = round == 0 ? 7 - pp : pp;
        const int b = bh >> 2, h = bh & 3;
        u.a = sc + ((size_t)bh * 2048 * 2048 + (size_t)pm * 256 * 2048) * 2; u.b = vt + ((size_t)(h * 512 + pn * 256) * T_ + b * 2048) * 2;
        u.nt = 4 * (pm + 1); u.pm = pm; u.pn = pn; u.job = bh; u.ro = 0; return true;
    }
};

struct CvtTask { unsigned long long src, dst; int ld_src, Ksrc, Nsrc, koff, ld_dst, Nd, Kd, swF, tbase, ntiles, p0, p1; };
constexpr int NCVT = 72;
__device__ __forceinline__ void make_task(const Ctx& X, int i, CvtTask& t) {
    const float* src = nullptr; size_t dst = 0; int ld_src = 1024, Ksrc = 1024, Nsrc = 1024, koff = 0, ld_dst = 1024, Nd = 1024, Kd = 1024, swF = 0;
    if (i == 0) { src = X.in(6); dst = OFF_WA_IN; ld_src = 3072; Nsrc = 3072; Nd = 3072; }
    else if (i == 1) { src = X.in(8); dst = OFF_WA_OUT; }
    else if (i < 5) { const int j = i - 2; src = X.in(10 + j); dst = OFF_WB_RKV + (size_t)j * 1024 * 1024 * 2; }
    else if (i < 8) { const int j = i - 5; src = X.in(j == 0 ? 14 : (j == 1 ? 17 : 19)); Nsrc = j == 2 ? 160 : 64; ld_src = Nsrc; Nd = 256; dst = OFF_WB_L1 + (size_t)j * 256 * 1024 * 2; }
    else if (i < 11) { const int j = i - 8; src = X.in(j == 0 ? 15 : (j == 1 ? 18 : 20)); Ksrc = j == 2 ? 160 : 64; Kd = 256; ld_dst = 256; dst = OFF_WB_L2 + (size_t)j * 1024 * 256 * 2; }
    else if (i == 11) { src = X.in(26); dst = OFF_WB_O; }
    else if (i == 12) { src = X.in(27); dst = OFF_WC_IN; ld_src = 2560; Nsrc = 2560; Nd = 2560; }
    else if (i < 33) { const int idx = i - 13, gp = idx / 4, q = (idx / 2) % 2, hs = idx % 2;
        src = X.in(hs ? 32 : 30) + (size_t)(2 * gp + q) * 128 * 128; ld_src = 128; Ksrc = 128; Nsrc = 128; koff = 128 * q;
        dst = OFF_WC_G + ((size_t)(gp * 512 + 256 * q + 128 * hs) * 256) * 2; ld_dst = 256; Nd = 128; Kd = 256; }
    else if (i == 33) { src = X.in(35); dst = OFF_WC_OUT; Ksrc = 1280; Kd = 1280; ld_dst = 1280; }
    else if (i == 34) { src = X.in(36); dst = OFF_WD_IN; ld_src = 6144; Nsrc = 6144; Nd = 6144; }
    else if (i == 35) { src = X.in(37); dst = OFF_WD_O; Ksrc = 2048; Kd = 2048; ld_dst = 2048; }
    else if (i < 38) { const int l = i - 36; src = X.in(38) + (size_t)l * 1024 * 5632; ld_src = 5632; Nsrc = 5632; Nd = 5632; swF = DFF; dst = OFF_WF_GU + (size_t)l * 5632 * 1024 * 2; }
    else if (i < 40) { const int l = i - 38; src = X.in(39) + (size_t)l * 2816 * 1024; Ksrc = 2816; Kd = 2816; ld_dst = 2816; dst = OFF_WF_DN + (size_t)l * 1024 * 2816 * 2; }
    else if (i < 56) { const int le = i - 40; src = X.in(41) + (size_t)le * 1024 * 7168; ld_src = 7168; Nsrc = 7168; Nd = 7168; swF = DFE; dst = OFF_WM_GU + (size_t)le * 7168 * 1024 * 2; }
    else { const int le = i - 56; src = X.in(42) + (size_t)le * 3584 * 1024; Ksrc = 3584; Kd = 3584; ld_dst = 3584; dst = OFF_WM_DN + (size_t)le * 1024 * 3584 * 2; }
    t.src = (unsigned long long)src; t.dst = (unsigned long long)(X.ws + dst); t.ld_src = ld_src; t.Ksrc = Ksrc; t.Nsrc = Nsrc; t.koff = koff; t.ld_dst = ld_dst; t.Nd = Nd; t.Kd = Kd; t.swF = swF;
    t.ntiles = (Nd / 32) * (Kd / 64); t.tbase = 0; t.p0 = 0; t.p1 = 0;
}

__device__ __forceinline__ void ph_prologue(const Ctx& X) {
    LAS int* tasks = (LAS int*)(X.lds + MISC_OFF + 1024);
    LAS int* total_p = (LAS int*)(X.lds + MISC_OFF + 512);
    if (X.tid < NCVT) { CvtTask t; make_task(X, X.tid, t); LAS int* q = tasks + X.tid * 16;
        q[0] = (int)(unsigned)t.src; q[1] = (int)(unsigned)(t.src >> 32); q[2] = (int)(unsigned)t.dst; q[3] = (int)(unsigned)(t.dst >> 32);
        q[4] = t.ld_src; q[5] = t.Ksrc; q[6] = t.Nsrc; q[7] = t.koff; q[8] = t.ld_dst; q[9] = t.Nd; q[10] = t.Kd; q[11] = t.swF; q[12] = 0; q[13] = t.ntiles; }
    __syncthreads();
    if (X.tid == 0) { int acc = 0; for (int i = 0; i < NCVT; ++i) { tasks[i * 16 + 12] = acc; acc += tasks[i * 16 + 13]; } *total_p = acc; }
    __syncthreads();
    const int total = *total_p;
    {
        LAS unsigned char* tl = X.lds + X.wave * 4608;
        const int sub = X.lane >> 3, q4 = X.lane & 7;
        int ti = 0;
        for (int id = X.bid * 8 + X.wave; id < total; id += X.G * 8) {
            while (ti + 1 < NCVT && id >= tasks[(ti + 1) * 16 + 12]) ++ti;
            CvtTask t; { const LAS int* q = tasks + ti * 16;
                t.src = ((unsigned long long)(unsigned)q[1] << 32) | (unsigned)q[0]; t.dst = ((unsigned long long)(unsigned)q[3] << 32) | (unsigned)q[2];
                t.ld_src = q[4]; t.Ksrc = q[5]; t.Nsrc = q[6]; t.koff = q[7]; t.ld_dst = q[8]; t.Nd = q[9]; t.Kd = q[10]; t.swF = q[11]; t.tbase = q[12]; t.ntiles = q[13]; }
            const int loc = id - t.tbase, ntn = t.Nd / 32, tk = loc / ntn, tn = loc % ntn;
            const int nd0 = tn * 32;
            int n0 = nd0;
            if (t.swF) { const int pp = nd0 >> 8, hh = (nd0 >> 7) & 1, jj = nd0 & 127; n0 = hh * t.swF + pp * 128 + jj; }
            const bool nval = (n0 + q4 * 4) < t.Nsrc;
            const float* src = (const float*)t.src;
            f32x4 v0[4], v1[4];
#pragma unroll
            for (int s = 0; s < 4; ++s) {
                const int kd = tk * 64 + s * 16 + sub * 2, ks = kd - t.koff;
                const bool ok0 = nval && ks >= 0 && ks < t.Ksrc, ok1 = nval && (ks + 1) >= 0 && (ks + 1) < t.Ksrc;
                v0[s] = ok0 ? *(const f32x4*)(src + (size_t)ks * t.ld_src + n0 + q4 * 4) : (f32x4){0.f, 0.f, 0.f, 0.f};
                v1[s] = ok1 ? *(const f32x4*)(src + (size_t)(ks + 1) * t.ld_src + n0 + q4 * 4) : (f32x4){0.f, 0.f, 0.f, 0.f};
            }
#pragma unroll
            for (int s = 0; s < 4; ++s)
#pragma unroll
                for (int j = 0; j < 4; ++j) *(LAS unsigned*)(tl + (q4 * 4 + j) * 144 + (s * 16 + sub * 2) * 2) = pk_bf16(v0[s][j], v1[s][j]);
            asm volatile("s_waitcnt lgkmcnt(0)" ::: "memory"); __builtin_amdgcn_wave_barrier();
            bf16_t* dst = (bf16_t*)t.dst;
#pragma unroll
            for (int s = 0; s < 4; ++s) { const int n = s * 8 + sub;
                const u32x4 w = *(const LAS u32x4*)(tl + n * 144 + q4 * 16);
                *(u32x4*)(dst + (size_t)(nd0 + n) * t.ld_dst + tk * 64 + q4 * 8) = w; }
            asm volatile("s_waitcnt lgkmcnt(0)" ::: "memory"); __builtin_amdgcn_wave_barrier();
        }
    }
    const int gt = X.bid * NTHREADS + X.tid, gs = X.G * NTHREADS;
    { const float* x = X.in(0); bf16_t* xb = X.w<bf16_t>(OFF_XB);
      for (int i = gt; i < T_ * D_ / 8; i += gs) { const f32x4 a = *(const f32x4*)(x + (size_t)i * 8), b = *(const f32x4*)(x + (size_t)i * 8 + 4); store8_bf16(xb + (size_t)i * 8, a, b); } }
    { const int* pos = (const int*)X.in(1); float* rc = X.w<float>(OFF_ROT); float* rs = rc + (size_t)T_ * 128;
      for (int i = gt; i < T_ * 128; i += gs) { const int t = i >> 7, j = i & 127;
          const double fr = exp(-((double)j / 127.0) * 9.210340371976184);
          double rev = (double)pos[t] * fr * 0.15915494309189535; rev -= rint(rev);
          rc[i] = __builtin_amdgcn_cosf((float)rev); rs[i] = __builtin_amdgcn_sinf((float)rev); } }
}

template <bool MOE>
__device__ __forceinline__ void ph_ln(const Ctx& X, const float* pre, const float* g, const float* b, float* xo, bf16_t* xb, const float* xin, const bf16_t* om, const int* route) {
    const int c0 = X.lane * 4;
    f32x4 gv[4], bv[4];
#pragma unroll
    for (int i = 0; i < 4; ++i) { gv[i] = *(const f32x4*)(g + c0 + 256 * i); bv[i] = *(const f32x4*)(b + c0 + 256 * i); }
    for (int row = X.bid * 8 + X.wave; row < T_; row += X.G * 8) {
        f32x4 v[4];
        if (!MOE) {
#pragma unroll
            for (int i = 0; i < 4; ++i) v[i] = *(const f32x4*)(pre + (size_t)row * D_ + c0 + 256 * i);
        } else {
            const int s1 = route[row * 8 + 6], s2 = route[row * 8 + 7]; const float p1 = __int_as_float(route[row * 8 + 4]), p2 = __int_as_float(route[row * 8 + 5]);
#pragma unroll
            for (int i = 0; i < 4; ++i) { const f32x4 xv = *(const f32x4*)(xin + (size_t)row * D_ + c0 + 256 * i);
                const u32x2 w1 = *(const u32x2*)(om + (size_t)s1 * D_ + c0 + 256 * i), w2 = *(const u32x2*)(om + (size_t)s2 * D_ + c0 + 256 * i);
                v[i][0] = ALPHA * xv[0] + p1 * bf_lo(w1.x) + p2 * bf_lo(w2.x); v[i][1] = ALPHA * xv[1] + p1 * bf_hi(w1.x) + p2 * bf_hi(w2.x);
                v[i][2] = ALPHA * xv[2] + p1 * bf_lo(w1.y) + p2 * bf_lo(w2.y); v[i][3] = ALPHA * xv[3] + p1 * bf_hi(w1.y) + p2 * bf_hi(w2.y); }
        }
        float s = 0.f;
#pragma unroll
        for (int i = 0; i < 4; ++i) s += (v[i][0] + v[i][1]) + (v[i][2] + v[i][3]);
        const float mean = wave_sum(s) * (1.0f / D_);
        float q = 0.f;
#pragma unroll
        for (int i = 0; i < 4; ++i) { const f32x4 d = v[i] - mean; q += (d[0] * d[0] + d[1] * d[1]) + (d[2] * d[2] + d[3] * d[3]); }
        const float rstd = rsqrtf(wave_sum(q) * (1.0f / D_) + LN_EPS);
#pragma unroll
        for (int i = 0; i < 4; ++i) { const f32x4 o = (v[i] - mean) * rstd * gv[i] + bv[i];
            *(f32x4*)(xo + (size_t)row * D_ + c0 + 256 * i) = o;
            if (xb) { u32x2 w; w.x = pk_bf16(o[0], o[1]); w.y = pk_bf16(o[2], o[3]); *(u32x2*)(xb + (size_t)row * D_ + c0 + 256 * i) = w; } }
    }
}

__device__ __forceinline__ void ph_convgate(const Ctx& X) {
    const bf16_t* bcv = X.w<bf16_t>(A0_BCV); bf16_t* ya = X.w<bf16_t>(A0_YA); const float* cw = X.in(7);
    for (int i = X.bid * NTHREADS + X.tid; i < T_ * 128; i += X.G * NTHREADS) {
        const int t = i >> 7, c8 = (i & 127) * 8, s = t & (S_ - 1);
        float acc[8];
#pragma unroll
        for (int j = 0; j < 8; ++j) acc[j] = 0.f;
#pragma unroll
        for (int k = 0; k < 3; ++k) { const int dt = 2 - k;
            if (s - dt >= 0) { const bf16_t* rowp = bcv + (size_t)(t - dt) * 3072;
                const u32x4 cc = *(const u32x4*)(rowp + 1024 + c8), vv = *(const u32x4*)(rowp + 2048 + c8);
                const f32x4 w0 = *(const f32x4*)(cw + k * 1024 + c8), w1 = *(const f32x4*)(cw + k * 1024 + c8 + 4);
                const unsigned cw4[4] = {cc.x, cc.y, cc.z, cc.w}, vw4[4] = {vv.x, vv.y, vv.z, vv.w};
#pragma unroll
                for (int j = 0; j < 4; ++j) { const float wl = j < 2 ? w0[2 * j] : w1[2 * j - 4], wh = j < 2 ? w0[2 * j + 1] : w1[2 * j - 3];
                    acc[2 * j] += wl * (bf_lo(cw4[j]) * bf_lo(vw4[j])); acc[2 * j + 1] += wh * (bf_hi(cw4[j]) * bf_hi(vw4[j])); } } }
        const u32x4 bb = *(const u32x4*)(bcv + (size_t)t * 3072 + c8); const unsigned bw[4] = {bb.x, bb.y, bb.z, bb.w};
        u32x4 o; unsigned ow[4];
#pragma unroll
        for (int j = 0; j < 4; ++j) ow[j] = pk_bf16(bf_lo(bw[j]) * acc[2 * j], bf_hi(bw[j]) * acc[2 * j + 1]);
        o.x = ow[0]; o.y = ow[1]; o.z = ow[2]; o.w = ow[3];
        *(u32x4*)(ya + (size_t)t * D_ + c8) = o;
    }
}

__device__ __forceinline__ void ph_rwkv_mix(const Ctx& X) {
    const float* x = X.w<float>(OFF_X); const float* mix = X.in(9); bf16_t* xm = X.w<bf16_t>(A1_XMIX);
    for (int i = X.bid * NTHREADS + X.tid; i < T_ * 256; i += X.G * NTHREADS) {
        const int t = i >> 8, c4 = (i & 255) * 4, s = t & (S_ - 1);
        const f32x4 cur = *(const f32x4*)(x + (size_t)t * D_ + c4);
        const f32x4 prv = s > 0 ? *(const f32x4*)(x + (size_t)(t - 1) * D_ + c4) : (f32x4){0.f, 0.f, 0.f, 0.f};
        const f32x4 xx = prv - cur;
#pragma unroll
        for (int j = 0; j < 6; ++j) { const f32x4 m = *(const f32x4*)(mix + j * D_ + c4); const f32x4 o = cur + xx * m;
            u32x2 w; w.x = pk_bf16(o[0], o[1]); w.y = pk_bf16(o[2], o[3]); *(u32x2*)(xm + (size_t)j * T_ * D_ + (size_t)t * D_ + c4) = w; }
    }
}

constexpr int RW_TC = 32;
__device__ __forceinline__ void ph_rwkv_scan(const Ctx& X) {
    const bf16_t* rkv = X.w<bf16_t>(A1_RKV); const float* o3 = X.w<float>(A1_O3); float* yout = X.w<float>(A1_Y);
    const float* k_k = X.in(21); const float* k_a = X.in(22);
    LAS float* buf = (LAS float*)X.lds;
    LAS float* vbuf = buf + 2 * RW_TC * 320;
    LAS float* ybuf = vbuf + 2 * RW_TC * 32;
    const int tid = X.tid, row = tid >> 4, seg = tid & 15;
    for (int unit = X.bid; unit < 256; unit += X.G) {
        const int bh = unit >> 1, half = unit & 1, b = bh >> 4, h = bh & 15;
        const int tl = tid >> 4, ks = tid & 15, col = h * 64 + ks * 4;
        const f32x4 kkv = *(const f32x4*)(k_k + col), kav = *(const f32x4*)(k_a + col);
        const int tvl = tid >> 3, vs = tid & 7;
        f32x2 s01 = {0.f, 0.f}, s23 = {0.f, 0.f};
        u32x2 raw_r, raw_k, raw_v = {0u, 0u}; f32x4 raw_d, raw_a;
        __syncthreads();
#define RW_LOAD(ch) do { const size_t tok = (size_t)b * S_ + (size_t)(ch) * RW_TC + tl; \
            raw_r = *(const u32x2*)(rkv + tok * D_ + col); raw_k = *(const u32x2*)(rkv + (size_t)T_ * D_ + tok * D_ + col); \
            raw_d = *(const f32x4*)(o3 + tok * D_ + col); raw_a = *(const f32x4*)(o3 + (size_t)T_ * D_ + tok * D_ + col); \
            if (tid < 256) { const size_t tokv = (size_t)b * S_ + (size_t)(ch) * RW_TC + tvl; raw_v = *(const u32x2*)(rkv + (size_t)2 * T_ * D_ + tokv * D_ + h * 64 + half * 32 + vs * 4); } } while (0)
#define RW_PUT(pb) do { const f32x4 k4 = {bf_lo(raw_k.x), bf_hi(raw_k.x), bf_lo(raw_k.y), bf_hi(raw_k.y)}; const f32x4 r4 = {bf_lo(raw_r.x), bf_hi(raw_r.x), bf_lo(raw_r.y), bf_hi(raw_r.y)}; \
            f32x4 kn = k4 * kkv; const float n2 = allreduce16((kn[0] * kn[0] + kn[1] * kn[1]) + (kn[2] * kn[2] + kn[3] * kn[3])); \
            const float inv = 1.0f / fmaxf(sqrtf(n2), 1e-12f); kn = kn * inv; \
            const f32x4 kp = k4 * (1.0f + (raw_a - 1.0f) * kav); \
            LAS float* q = buf + ((pb) * RW_TC + tl) * 320 + ks * 4; \
            *(LAS f32x4*)(q) = raw_d; *(LAS f32x4*)(q + 64) = kp; *(LAS f32x4*)(q + 128) = -kn; *(LAS f32x4*)(q + 192) = kn * raw_a; *(LAS f32x4*)(q + 256) = r4; \
            if (tid < 256) { const f32x4 v4 = {bf_lo(raw_v.x), bf_hi(raw_v.x), bf_lo(raw_v.y), bf_hi(raw_v.y)}; *(LAS f32x4*)(vbuf + ((pb) * RW_TC + tvl) * 32 + vs * 4) = v4; } } while (0)
        RW_LOAD(0); RW_PUT(0);
        __syncthreads();
        constexpr int NCH = S_ / RW_TC;
        for (int ch = 0; ch < NCH; ++ch) {
            const int pb = ch & 1;
            if (ch + 1 < NCH) RW_LOAD(ch + 1);
            const LAS float* bb = buf + pb * RW_TC * 320 + seg * 4; const LAS float* vb = vbuf + pb * RW_TC * 32 + row; LAS float* yb = ybuf + pb * RW_TC * 32 + row;
#pragma unroll 4
            for (int t = 0; t < RW_TC; ++t) {
                const f32x4 w = *(const LAS f32x4*)(bb + t * 320), kp = *(const LAS f32x4*)(bb + t * 320 + 64), as = *(const LAS f32x4*)(bb + t * 320 + 128);
                const f32x4 bs = *(const LAS f32x4*)(bb + t * 320 + 192), r4 = *(const LAS f32x4*)(bb + t * 320 + 256);
                const float v = vb[t * 32];
                const f32x2 p = s01 * (f32x2){as[0], as[1]} + s23 * (f32x2){as[2], as[3]};
                const float sa = allreduce16(p.x + p.y);
                s01 = s01 * (f32x2){w[0], w[1]} + ((f32x2){bs[0], bs[1]} * sa + (f32x2){kp[0], kp[1]} * v);
                s23 = s23 * (f32x2){w[2], w[3]} + ((f32x2){bs[2], bs[3]} * sa + (f32x2){kp[2], kp[3]} * v);
                const f32x2 yq = s01 * (f32x2){r4[0], r4[1]} + s23 * (f32x2){r4[2], r4[3]};
                const float y = allreduce16(yq.x + yq.y);
                if (seg == 0) yb[t * 32] = y;
            }
            if (ch + 1 < NCH) RW_PUT(pb ^ 1);
            __syncthreads();
            { const int t = tid >> 4, rr = (tid & 15) * 2; const f32x2 yy = *(const LAS f32x2*)(ybuf + (pb * RW_TC + t) * 32 + rr);
              *(f32x2*)(yout + ((size_t)b * S_ + (size_t)ch * RW_TC + t) * D_ + h * 64 + half * 32 + rr) = yy; }
        }
#undef RW_LOAD
#undef RW_PUT
    }
}

__device__ __forceinline__ void ph_rwkv_post(const Ctx& X) {
    const bf16_t* rkv = X.w<bf16_t>(A1_RKV); const float* o3 = X.w<float>(A1_O3); const float* y = X.w<float>(A1_Y); bf16_t* yb = X.w<bf16_t>(A1_YB);
    const float* k_a = X.in(22); const float* r_k = X.in(23); const float* gn_g = X.in(24); const float* gn_b = X.in(25);
    const int c4 = (X.tid & 255) * 4;
    const f32x4 kav = *(const f32x4*)(k_a + c4), rkk = *(const f32x4*)(r_k + c4), gg = *(const f32x4*)(gn_g + c4), gb = *(const f32x4*)(gn_b + c4);
    for (int t = X.bid * 2 + (X.tid >> 8); t < T_; t += X.G * 2) {
        const size_t o = (size_t)t * D_ + c4;
        const f32x4 yv = *(const f32x4*)(y + o), av = *(const f32x4*)(o3 + (size_t)T_ * D_ + o), gv = *(const f32x4*)(o3 + (size_t)2 * T_ * D_ + o);
        const u32x2 rw = *(const u32x2*)(rkv + o), kw = *(const u32x2*)(rkv + (size_t)T_ * D_ + o), vw = *(const u32x2*)(rkv + (size_t)2 * T_ * D_ + o);
        const f32x4 r4 = {bf_lo(rw.x), bf_hi(rw.x), bf_lo(rw.y), bf_hi(rw.y)}, k4 = {bf_lo(kw.x), bf_hi(kw.x), bf_lo(kw.y), bf_hi(kw.y)}, v4 = {bf_lo(vw.x), bf_hi(vw.x), bf_lo(vw.y), bf_hi(vw.y)};
        const f32x4 kp = k4 * (1.0f + (av - 1.0f) * kav);
        const float mu = allreduce16((yv[0] + yv[1]) + (yv[2] + yv[3])) * (1.0f / 64.0f);
        const f32x4 d = yv - mu;
        const float var = allreduce16((d[0] * d[0] + d[1] * d[1]) + (d[2] * d[2] + d[3] * d[3])) * (1.0f / 64.0f);
        const f32x4 rk = r4 * kp * rkk;
        const float bonus = allreduce16((rk[0] + rk[1]) + (rk[2] + rk[3]));
        const f32x4 out = (d * rsqrtf(var + 64e-5f) * gg + gb + v4 * bonus) * gv;
        u32x2 w; w.x = pk_bf16(out[0], out[1]); w.y = pk_bf16(out[2], out[3]); *(u32x2*)(yb + o) = w;
    }
}

__device__ __forceinline__ void ph_route(const Ctx& X, const float* x, const float* wr, unsigned* cnt, int* route) {
    LAS float* wl = (LAS float*)X.lds;
    LAS int* lcnt = (LAS int*)(X.lds + 32768);
    LAS int* ltok = (LAS int*)(X.lds + 32768 + 64);
    for (int i = X.tid; i < 8192; i += NTHREADS) wl[i] = wr[i];
    if (X.tid < 16) lcnt[X.tid] = 0;
    __syncthreads();
    const int per = (T_ + X.G - 1) / X.G;
    const int t0 = X.bid * per, t1 = (t0 + per) < T_ ? (t0 + per) : T_;
    for (int t = t0 + X.wave; t < t1; t += 8) {
        float acc[8];
#pragma unroll
        for (int e = 0; e < 8; ++e) acc[e] = 0.f;
#pragma unroll
        for (int i = 0; i < 4; ++i) { const f32x4 xv = *(const f32x4*)(x + (size_t)t * D_ + X.lane * 4 + 256 * i);
#pragma unroll
            for (int j = 0; j < 4; ++j) { const LAS float* wp = wl + (X.lane * 4 + 256 * i + j) * 8; const f32x4 wa = *(const LAS f32x4*)wp, wb = *(const LAS f32x4*)(wp + 4);
                acc[0] += xv[j] * wa[0]; acc[1] += xv[j] * wa[1]; acc[2] += xv[j] * wa[2]; acc[3] += xv[j] * wa[3];
                acc[4] += xv[j] * wb[0]; acc[5] += xv[j] * wb[1]; acc[6] += xv[j] * wb[2]; acc[7] += xv[j] * wb[3]; } }
#pragma unroll
        for (int e = 0; e < 8; ++e) acc[e] = wave_sum(acc[e]);
        if (X.lane == 0) {
            int e1 = 0; float v1 = acc[0];
#pragma unroll
            for (int e = 1; e < 8; ++e) if (acc[e] > v1) { v1 = acc[e]; e1 = e; }
            int e2 = -1; float v2 = -3.0e38f;
#pragma unroll
            for (int e = 0; e < 8; ++e) if (e != e1 && acc[e] > v2) { v2 = acc[e]; e2 = e; }
            if (e2 < 0) { e2 = (e1 + 1) & 7; v2 = acc[e2]; }
            const float p1 = 1.0f / (1.0f + __expf(v2 - v1)), p2 = 1.0f - p1;
            const int li1 = atomicAdd((int*)(lcnt + e1), 1), li2 = atomicAdd((int*)(lcnt + e2), 1);
            LAS int* q = ltok + (t - t0) * 6; q[0] = e1; q[1] = e2; q[2] = li1; q[3] = li2; q[4] = __float_as_int(p1); q[5] = __float_as_int(p2);
        }
    }
    __syncthreads();
    if (X.tid < 8) lcnt[8 + X.tid] = (int)__hip_atomic_fetch_add(cnt + X.tid, (unsigned)lcnt[X.tid], __ATOMIC_RELAXED, __HIP_MEMORY_SCOPE_AGENT);
    __syncthreads();
    for (int i = X.tid; i < t1 - t0; i += NTHREADS) { const LAS int* q = ltok + i * 6; int* o = route + (size_t)(t0 + i) * 8;
        o[0] = q[0]; o[1] = q[1]; o[2] = lcnt[8 + q[0]] + q[2]; o[3] = lcnt[8 + q[1]] + q[3]; o[4] = q[4]; o[5] = q[5]; }
    __syncthreads();
}

__device__ __forceinline__ int moe_jobs(const Ctx& X, const unsigned* cnt, const bf16_t* A, int lda_elems, const bf16_t* W, size_t w_stride, int nN, int nt) {
    LAS int* total_p = (LAS int*)(X.lds + MISC_OFF + 512);
    if (X.tid == 0) { int off = 0, base = 0;
        for (int e = 0; e < 8; ++e) { const int c = (int)__hip_atomic_load(cnt + e, __ATOMIC_RELAXED, __HIP_MEMORY_SCOPE_AGENT), nM = (c + 255) >> 8;
            set_job(X, e, A + (size_t)off * lda_elems, W + (size_t)e * w_stride, nM, nN, nt, base, off); off += nM * 256; base += nM * nN; }
        *total_p = base; }
    __syncthreads();
    return *total_p;
}
__device__ __forceinline__ void ph_gather(const Ctx& X, const unsigned* cnt, int* route) {
    LAS int* offs = (LAS int*)X.lds;
    if (X.tid == 0) { int off = 0; for (int e = 0; e < 8; ++e) { const int c = (int)__hip_atomic_load(cnt + e, __ATOMIC_RELAXED, __HIP_MEMORY_SCOPE_AGENT); offs[e] = off; offs[8 + e] = c; off += ((c + 255) >> 8) << 8; } }
    __syncthreads();
    const bf16_t* xb = X.w<bf16_t>(OFF_XB); bf16_t* xg = X.w<bf16_t>(AM_XG);
    for (int t = X.bid * 8 + X.wave; t < T_; t += X.G * 8) {
        const int e1 = route[t * 8 + 0], e2 = route[t * 8 + 1], s1 = offs[e1] + route[t * 8 + 2], s2 = offs[e2] + route[t * 8 + 3];
        const u32x4 a = *(const u32x4*)(xb + (size_t)t * D_ + X.lane * 8), b = *(const u32x4*)(xb + (size_t)t * D_ + 512 + X.lane * 8);
        *(u32x4*)(xg + (size_t)s1 * D_ + X.lane * 8) = a; *(u32x4*)(xg + (size_t)s1 * D_ + 512 + X.lane * 8) = b;
        *(u32x4*)(xg + (size_t)s2 * D_ + X.lane * 8) = a; *(u32x4*)(xg + (size_t)s2 * D_ + 512 + X.lane * 8) = b;
        if (X.lane == 0) { route[t * 8 + 6] = s1; route[t * 8 + 7] = s2; }
    }
    for (int e = 0; e < 8; ++e) { const int c = offs[8 + e], r0 = offs[e] + c, r1 = offs[e] + (((c + 255) >> 8) << 8);
        for (int r = r0 + X.bid * 8 + X.wave; r < r1; r += X.G * 8) { const u32x4 z = {0u, 0u, 0u, 0u};
            *(u32x4*)(xg + (size_t)r * D_ + X.lane * 8) = z; *(u32x4*)(xg + (size_t)r * D_ + 512 + X.lane * 8) = z; } }
    __syncthreads();
}

__device__ __forceinline__ void ph_conv4(const Ctx& X) {
    const bf16_t* uu = X.w<bf16_t>(A2_UU); bf16_t* uc = X.w<bf16_t>(A2_UC); const float* cw = X.in(28); const float* cb = X.in(29);
    for (int i = X.bid * NTHREADS + X.tid; i < T_ * 160; i += X.G * NTHREADS) {
        const int t = i / 160, c8 = (i % 160) * 8, s = t & (S_ - 1);
        float acc[8];
        { const f32x4 b0 = *(const f32x4*)(cb + c8), b1 = *(const f32x4*)(cb + c8 + 4);
#pragma unroll
          for (int j = 0; j < 4; ++j) { acc[j] = b0[j]; acc[4 + j] = b1[j]; } }
#pragma unroll
        for (int k = 0; k < 4; ++k) { const int dt = 3 - k;
            if (s - dt >= 0) { const u32x4 uv = *(const u32x4*)(uu + (size_t)(t - dt) * DRNN + c8); const unsigned uw[4] = {uv.x, uv.y, uv.z, uv.w};
                const f32x4 w0 = *(const f32x4*)(cw + k * DRNN + c8), w1 = *(const f32x4*)(cw + k * DRNN + c8 + 4);
                acc[0] += w0[0] * bf_lo(uw[0]); acc[1] += w0[1] * bf_hi(uw[0]); acc[2] += w0[2] * bf_lo(uw[1]); acc[3] += w0[3] * bf_hi(uw[1]);
                acc[4] += w1[0] * bf_lo(uw[2]); acc[5] += w1[1] * bf_hi(uw[2]); acc[6] += w1[2] * bf_lo(uw[3]); acc[7] += w1[3] * bf_hi(uw[3]); } }
        u32x4 o; o.x = pk_bf16(acc[0], acc[1]); o.y = pk_bf16(acc[2], acc[3]); o.z = pk_bf16(acc[4], acc[5]); o.w = pk_bf16(acc[6], acc[7]);
        *(u32x4*)(uc + (size_t)t * DRNN + c8) = o;
    }
}

__device__ __forceinline__ void ph_lru_scan(const Ctx& X) {
    const float* at = X.w<float>(A2_AT); const float* bt = X.w<float>(A2_BT); const bf16_t* gg = X.w<bf16_t>(A2_GG); bf16_t* yc = X.w<bf16_t>(A2_YC);
    LAS float* agg = (LAS float*)X.lds;
    const int sg = X.tid >> 6, cl = X.tid & 63;
    for (int unit = X.bid; unit < 8 * 20; unit += X.G) {
        const int b = unit / 20, ch = (unit % 20) * 64 + cl;
        const size_t base = ((size_t)b * S_ + (size_t)sg * 256) * DRNN + ch;
        float A = 1.f, H = 0.f;
#pragma unroll 8
        for (int t = 0; t < 256; ++t) { const float a = at[base + (size_t)t * DRNN], bb = bt[base + (size_t)t * DRNN]; H = a * H + bb; A *= a; }
        __syncthreads();
        agg[(sg * 2 + 0) * 64 + cl] = A; agg[(sg * 2 + 1) * 64 + cl] = H;
        __syncthreads();
        float hin = 0.f;
        for (int s2 = 0; s2 < sg; ++s2) hin = agg[(s2 * 2 + 0) * 64 + cl] * hin + agg[(s2 * 2 + 1) * 64 + cl];
        float h = hin;
#pragma unroll 8
        for (int t = 0; t < 256; ++t) { const float a = at[base + (size_t)t * DRNN], bb = bt[base + (size_t)t * DRNN]; h = a * h + bb;
            const float g = bf1(gg[base + (size_t)t * DRNN]); const unsigned w = pk_bf16(g * h, 0.f); yc[base + (size_t)t * DRNN] = (bf16_t)(w & 0xffffu); }
    }
    __syncthreads();
}

__device__ __forceinline__ void ph_ret_post(const Ctx& X) {
    const bf16_t* y = X.w<bf16_t>(A3_Y); const bf16_t* gs = X.w<bf16_t>(A3_GS); bf16_t* yd = X.w<bf16_t>(A3_YD);
    for (int i = X.bid * 8 + X.wave; i < T_ * 4; i += X.G * 8) {
        const size_t o = (size_t)i * 512 + X.lane * 8;
        const u32x4 yw = *(const u32x4*)(y + o), gw = *(const u32x4*)(gs + o);
        const unsigned ya[4] = {yw.x, yw.y, yw.z, yw.w}, ga[4] = {gw.x, gw.y, gw.z, gw.w};
        float v[8], q = 0.f;
#pragma unroll
        for (int j = 0; j < 4; ++j) { v[2 * j] = bf_lo(ya[j]); v[2 * j + 1] = bf_hi(ya[j]); q += v[2 * j] * v[2 * j] + v[2 * j + 1] * v[2 * j + 1]; }
        const float rs = rsqrtf(wave_sum(q) * (1.0f / 512.0f) + 1e-6f);
        u32x4 ow; unsigned oa[4];
#pragma unroll
        for (int j = 0; j < 4; ++j) oa[j] = pk_bf16(v[2 * j] * rs * bf_lo(ga[j]), v[2 * j + 1] * rs * bf_hi(ga[j]));
        ow.x = oa[0]; ow.y = oa[1]; ow.z = oa[2]; ow.w = oa[3];
        *(u32x4*)(yd + o) = ow;
    }
}

template <class Epi>
__device__ __forceinline__ void gemm1(const Ctx& X, const void* A, int lda, const void* Bt, int ldb, int nM, int nN, int K, const Epi& E) {
    __syncthreads();
    if (X.tid == 0) set_job(X, 0, A, Bt, nM, nN, K / 64, 0, 0);
    __syncthreads();
    const pg8::JobSched S = make_sched(X, 1, nM * nN, lda, ldb);
    pg8::gemm_phase(X.lds, lda, ldb, S, E);
    __syncthreads();
}

__device__ __forceinline__ void ph_ffn_gu(const Ctx& X, int l) { EpiSwiglu E{X.w<bf16_t>(AF_H), DFF}; gemm1(X, X.w<bf16_t>(OFF_XB), D_, X.w<bf16_t>(OFF_WF_GU) + (size_t)l * 5632 * 1024, D_, 64, 22, D_, E); }
__device__ __forceinline__ void ph_ffn_dn(const Ctx& X, int l, const float* xres) { EpiResid E{xres, X.w<float>(OFF_PRE)}; gemm1(X, X.w<bf16_t>(AF_H), DFF, X.w<bf16_t>(OFF_WF_DN) + (size_t)l * 1024 * 2816, DFF, 64, 4, DFF, E); }
__device__ __forceinline__ void ph_moe_gu(const Ctx& X, int l) {
    __syncthreads();
    const int total = moe_jobs(X, (const unsigned*)X.ws + CTL_MOE_CNT + l * 64, X.w<bf16_t>(AM_XG), D_, X.w<bf16_t>(OFF_WM_GU) + (size_t)l * 8 * 7168 * 1024, (size_t)7168 * 1024, 28, 16);
    EpiSwiglu E{X.w<bf16_t>(AM_H), DFE}; const pg8::JobSched S = make_sched(X, 8, total, D_, D_);
    pg8::gemm_phase(X.lds, D_, D_, S, E); __syncthreads();
}
__device__ __forceinline__ void ph_moe_dn(const Ctx& X, int l) {
    __syncthreads();
    const int total = moe_jobs(X, (const unsigned*)X.ws + CTL_MOE_CNT + l * 64, X.w<bf16_t>(AM_H), DFE, X.w<bf16_t>(OFF_WM_DN) + (size_t)l * 8 * 1024 * 3584, (size_t)1024 * 3584, 4, 56);
    EpiStoreBf16 E{X.w<bf16_t>(AM_O), D_}; const pg8::JobSched S = make_sched(X, 8, total, DFE, DFE);
    pg8::gemm_phase(X.lds, DFE, DFE, S, E); __syncthreads();
}

constexpr int N_PHASES = 40;
__global__ void __launch_bounds__(NTHREADS, 2) mega(Params p) {
    extern __shared__ __attribute__((aligned(16))) unsigned char lds_raw[];
    Ctx X; X.p = &p; X.ws = p.ws; X.lds = (LAS unsigned char*)lds_raw; X.tid = threadIdx.x; X.lane = X.tid & 63; X.wave = rfl(X.tid >> 6); X.G = gridDim.x; X.bid = blockIdx.x;
    const int lo = p.ph_lo, hi = p.ph_hi;
    if (X.tid < 4) ((LAS unsigned*)(X.lds + MISC_OFF))[X.tid] = 0u;
    __syncthreads();
    XcdBarrier bar; bar.bar = (unsigned*)X.ws; bar.x = 0; bar.st = (volatile LAS unsigned*)(X.lds + MISC_OFF);
    if (hi - lo > 1) bar = xcd_barrier_post((unsigned*)X.ws, (volatile LAS unsigned*)(X.lds + MISC_OFF));
#define PH(k, ...) if (lo <= (k) && (k) < hi) { __VA_ARGS__; if ((k) + 1 < hi) xcd_barrier(bar); }
    float* xs = X.w<float>(OFF_X); bf16_t* xb = X.w<bf16_t>(OFF_XB); float* pre = X.w<float>(OFF_PRE);
    unsigned* ctl = (unsigned*)X.ws; int* route = X.w<int>(OFF_ROUTE);
    const float* lmg = X.in(2); const float* lmb = X.in(3); const float* lfg = X.in(4); const float* lfb = X.in(5);

    PH(0, ph_prologue(X));
    PH(1, { EpiStoreBf16 E{X.w<bf16_t>(A0_BCV), 3072}; gemm1(X, xb, D_, X.w<bf16_t>(OFF_WA_IN), D_, 64, 12, D_, E); });
    PH(2, ph_convgate(X));
    PH(3, { EpiResid E{X.in(0), pre}; gemm1(X, X.w<bf16_t>(A0_YA), D_, X.w<bf16_t>(OFF_WA_OUT), D_, 64, 4, D_, E); });
    PH(4, ph_ln<false>(X, pre, lmg, lmb, xs, xb, nullptr, nullptr, nullptr));
    PH(5, ph_ffn_gu(X, 0));
    PH(6, ph_ffn_dn(X, 0, xs));
    PH(7, ph_ln<false>(X, pre, lfg, lfb, xs, xb, nullptr, nullptr, nullptr));
    PH(8, ph_rwkv_mix(X));
    PH(9, { __syncthreads();
            if (X.tid == 0) { const bf16_t* xm = X.w<bf16_t>(A1_XMIX); const bf16_t* wr = X.w<bf16_t>(OFF_WB_RKV); const bf16_t* w1 = X.w<bf16_t>(OFF_WB_L1);
                set_job(X, 0, xm + (size_t)0 * T_ * D_, wr + (size_t)0 * D_ * D_, 64, 4, 16, 0, 0);
                set_job(X, 1, xm + (size_t)2 * T_ * D_, wr + (size_t)1 * D_ * D_, 64, 4, 16, 256, 0);
                set_job(X, 2, xm + (size_t)3 * T_ * D_, wr + (size_t)2 * D_ * D_, 64, 4, 16, 512, 0);
                set_job(X, 3, xm + (size_t)1 * T_ * D_, w1 + (size_t)0 * 256 * D_, 64, 1, 16, 768, 0);
                set_job(X, 4, xm + (size_t)4 * T_ * D_, w1 + (size_t)1 * 256 * D_, 64, 1, 16, 832, 0);
                set_job(X, 5, xm + (size_t)5 * T_ * D_, w1 + (size_t)2 * 256 * D_, 64, 1, 16, 896, 0); }
            __syncthreads();
            EpiRwkv1 E{X.w<bf16_t>(A1_RKV), X.w<bf16_t>(A1_L1)}; const pg8::JobSched S = make_sched(X, 6, 960, D_, D_);
            pg8::gemm_phase(X.lds, D_, D_, S, E); __syncthreads(); });
    PH(10, { __syncthreads();
             if (X.tid == 0) { const bf16_t* l1 = X.w<bf16_t>(A1_L1); const bf16_t* w2 = X.w<bf16_t>(OFF_WB_L2);
                 for (int j = 0; j < 3; ++j) set_job(X, j, l1 + (size_t)j * T_ * 256, w2 + (size_t)j * 1024 * 256, 64, 4, 4, 256 * j, 0); }
             __syncthreads();
             EpiRwkv2 E{X.w<float>(A1_O3), X.in(13), X.in(16)}; const pg8::JobSched S = make_sched(X, 3, 768, 256, 256);
             pg8::gemm_phase(X.lds, 256, 256, S, E); __syncthreads(); });
    PH(11, ph_rwkv_scan(X));
    PH(12, ph_rwkv_post(X));
    PH(13, { EpiResid E{xs, pre}; gemm1(X, X.w<bf16_t>(A1_YB), D_, X.w<bf16_t>(OFF_WB_O), D_, 64, 4, D_, E); });
    PH(14, ph_ln<false>(X, pre, lmg + D_, lmb + D_, xs, xb, nullptr, nullptr, nullptr));
    PH(15, ph_route(X, xs, X.in(40), ctl + CTL_MOE_CNT, route));
    PH(16, ph_gather(X, ctl + CTL_MOE_CNT, route));
    PH(17, ph_moe_gu(X, 0));
    PH(18, ph_moe_dn(X, 0));
    PH(19, ph_ln<true>(X, nullptr, lfg + D_, lfb + D_, xs, xb, xs, X.w<bf16_t>(AM_O), route));
    PH(20, { EpiGriffinIn E{X.w<bf16_t>(A2_GG), X.w<bf16_t>(A2_UU)}; gemm1(X, xb, D_, X.w<bf16_t>(OFF_WC_IN), D_, 64, 10, D_, E); });
    PH(21, ph_conv4(X));
    PH(22, { __syncthreads();
             if (X.tid == 0) { const bf16_t* uc = X.w<bf16_t>(A2_UC); const bf16_t* wg = X.w<bf16_t>(OFF_WC_G);
                 for (int j = 0; j < 5; ++j) set_job(X, j, uc + j * 256, wg + (size_t)j * 512 * 256, 64, 2, 4, 128 * j, 0); }
             __syncthreads();
             EpiGates E{X.w<bf16_t>(A2_UC), X.in(31), X.in(33), X.in(34), (const int*)X.in(1), X.w<float>(A2_AT), X.w<float>(A2_BT)};
             const pg8::JobSched S = make_sched(X, 5, 640, DRNN, 256);
             pg8::gemm_phase(X.lds, DRNN, 256, S, E); __syncthreads(); });
    PH(23, ph_lru_scan(X));
    PH(24, { EpiResid E{xs, pre}; gemm1(X, X.w<bf16_t>(A2_YC), DRNN, X.w<bf16_t>(OFF_WC_OUT), DRNN, 64, 4, DRNN, E); });
    PH(25, ph_ln<false>(X, pre, lmg + 2 * D_, lmb + 2 * D_, xs, xb, nullptr, nullptr, nullptr));
    PH(26, ph_ffn_gu(X, 1));
    PH(27, ph_ffn_dn(X, 1, xs));
    PH(28, ph_ln<false>(X, pre, lfg + 2 * D_, lfb + 2 * D_, xs, xb, nullptr, nullptr, nullptr));
    PH(29, { __syncthreads();
             if (X.tid == 0) { const bf16_t* wd = X.w<bf16_t>(OFF_WD_IN);
                 set_job(X, 0, xb, wd, 64, 4, 16, 0, 0);
                 set_job(X, 1, xb, wd + (size_t)1024 * D_, 64, 4, 16, 256, 0);
                 set_job(X, 2, xb, wd + (size_t)4096 * D_, 64, 8, 16, 512, 0);
                 set_job(X, 3, wd + (size_t)2048 * D_, xb, 8, 64, 16, 1024, 0); }
             __syncthreads();
             const float* rc = X.w<float>(OFF_ROT);
             EpiRetIn E{X.w<bf16_t>(A3_QR), X.w<bf16_t>(A3_KR), X.w<bf16_t>(A3_GS), X.w<bf16_t>(A3_VT), rc, rc + (size_t)T_ * 128};
             const pg8::JobSched S = make_sched(X, 4, 1536, D_, D_);
             pg8::gemm_phase(X.lds, D_, D_, S, E); __syncthreads(); });
    PH(30, { __syncthreads(); EpiScores E{X.w<bf16_t>(A3_SC)}; ScoreSched S{(const char*)X.w<bf16_t>(A3_QR), (const char*)X.w<bf16_t>(A3_KR), X.G, X.bid};
             pg8::gemm_phase(X.lds, D_, D_, S, E); __syncthreads(); });
    PH(31, { __syncthreads(); EpiRetOut E{X.w<bf16_t>(A3_Y)}; RetOutSched S{(const char*)X.w<bf16_t>(A3_SC), (const char*)X.w<bf16_t>(A3_VT), X.G, X.bid};
             pg8::gemm_phase(X.lds, 2048, T_, S, E); __syncthreads(); });
    PH(32, ph_ret_post(X));
    PH(33, { EpiResid E{xs, pre}; gemm1(X, X.w<bf16_t>(A3_YD), 2048, X.w<bf16_t>(OFF_WD_O), 2048, 64, 4, 2048, E); });
    PH(34, ph_ln<false>(X, pre, lmg + 3 * D_, lmb + 3 * D_, xs, xb, nullptr, nullptr, nullptr));
    PH(35, ph_route(X, xs, X.in(40) + 8192, ctl + CTL_MOE_CNT + 64, route));
    PH(36, ph_gather(X, ctl + CTL_MOE_CNT + 64, route));
    PH(37, ph_moe_gu(X, 1));
    PH(38, ph_moe_dn(X, 1));
    PH(39, ph_ln<true>(X, nullptr, lfg + 3 * D_, lfb + 3 * D_, p.out, nullptr, xs, X.w<bf16_t>(AM_O), route));
#undef PH
}

extern "C" void kernel_launch(void* const* d_in, const int* in_sizes, int n_in, void* d_out, int out_size, void* d_ws, size_t ws_size, hipStream_t stream) {
    static int grid = 0;
    if (grid == 0) {
        if (n_in != 43 || ws_size < WS_NEED) { fprintf(stderr, "kernel_launch: need 43 inputs and %zu bytes of workspace (got %d, %zu)\n", (size_t)WS_NEED, n_in, ws_size); grid = -1; return; }
        int dev = 0, cus = 0, per_cu = 0;
        if (hipGetDevice(&dev) != hipSuccess || hipDeviceGetAttribute(&cus, hipDeviceAttributeMultiprocessorCount, dev) != hipSuccess) { grid = -1; return; }
        if (hipFuncSetAttribute((const void*)mega, hipFuncAttributeMaxDynamicSharedMemorySize, LDS_BYTES) != hipSuccess) { fprintf(stderr, "kernel_launch: hipFuncSetAttribute failed\n"); grid = -1; return; }
        if (hipOccupancyMaxActiveBlocksPerMultiprocessor(&per_cu, (const void*)mega, NTHREADS, LDS_BYTES) != hipSuccess || per_cu < 1) { fprintf(stderr, "kernel_launch: occupancy query says %d\n", per_cu); }
        (void)hipGetLastError();
        grid = cus;
    }
    if (grid < 0) return;
    (void)hipMemsetAsync(d_ws, 0, CTL_BYTES, stream);
    Params p{};
    for (int i = 0; i < 43; ++i) p.in[i] = (const float*)d_in[i];
    p.out = (float*)d_out; p.ws = (unsigned char*)d_ws;
#if MK_ONE_LAUNCH
    p.ph_lo = 0; p.ph_hi = N_PHASES;
    hipLaunchKernelGGL(mega, dim3(grid), dim3(NTHREADS), LDS_BYTES, stream, p);
#else
    for (int k = 0; k < N_PHASES; ++k) { p.ph_lo = k; p.ph_hi = k + 1; hipLaunchKernelGGL(mega, dim3(grid), dim3(NTHREADS), LDS_BYTES, stream, p); }
#endif
}
```

```cpp
#include <hip/hip_runtime.h>
#include <cstdio>
#include <cstdint>

#ifndef MK_ONE_LAUNCH
#define MK_ONE_LAUNCH 1
#endif

#define LAS __attribute__((address_space(3)))
typedef unsigned short bf16_t;
typedef short bf16x8 __attribute__((ext_vector_type(8)));
typedef float f32x4 __attribute__((ext_vector_type(4)));
typedef float f32x2 __attribute__((ext_vector_type(2)));
typedef unsigned u32x4 __attribute__((ext_vector_type(4)));
typedef unsigned u32x2 __attribute__((ext_vector_type(2)));

#define XB_TMO      128
#define XB_XCNT(j)  (256  + 64 * (j))
#define XB_XSUB(j)  (1280 + 64 * (j))
#define XB_XGEN(j)  (2304 + 64 * (j))
#define XB_TOP      3328
#define XB_TOPGEN   3392
#define XCD_BAR_WORDS 3456
#define XB_SPIN_CAP (1u << 18)

__device__ __forceinline__ unsigned xb_ld(unsigned* p)              { return __hip_atomic_load(p, __ATOMIC_RELAXED, __HIP_MEMORY_SCOPE_AGENT); }
__device__ __forceinline__ unsigned xb_add(unsigned* p, unsigned v) { return __hip_atomic_fetch_add(p, v, __ATOMIC_RELAXED, __HIP_MEMORY_SCOPE_AGENT); }
__device__ __forceinline__ unsigned xb_xcc_id() { return (unsigned)__builtin_amdgcn_s_getreg((3 << 11) | 20) & 0xFu; }
#define XB_SPIN(cond, bar) do { unsigned _sp = 0; while (cond) { __builtin_amdgcn_s_sleep(1); \
    if ((++_sp & 255u) == 0u) { if (xb_ld(&(bar)[XB_TMO])) break; if (_sp > XB_SPIN_CAP) { atomicAdd(&(bar)[XB_TMO], 1u); break; } } } } while (0)

struct XcdBarrier { unsigned* bar; unsigned x; volatile LAS unsigned* st; };

__device__ __forceinline__ XcdBarrier xcd_barrier_post(unsigned* bar, volatile LAS unsigned* st) {
    XcdBarrier b; b.bar = bar; b.x = xb_xcc_id(); b.st = st;
    if (threadIdx.x == 0) (void)xb_add(&bar[XB_XCNT(b.x)], 1u);
    return b;
}
__device__ __forceinline__ void xcd_barrier_complete(unsigned* bar, unsigned x, unsigned& nloc, unsigned& nx) {
    const unsigned G = gridDim.x * gridDim.y * gridDim.z;
    unsigned sum, cnt, mine, sp = 0u;
    for (;;) {
        sum = 0u; cnt = 0u; mine = 0u;
#pragma unroll
        for (unsigned j = 0; j < 16; ++j) { const unsigned c = xb_ld(&bar[XB_XCNT(j)]); sum += c; cnt += (c > 0u) ? 1u : 0u; mine = (j == x) ? c : mine; }
        if (sum == G) break;
        __builtin_amdgcn_s_sleep(1);
        if ((++sp & 255u) == 0u) { if (xb_ld(&bar[XB_TMO])) break; if (sp > XB_SPIN_CAP) { atomicAdd(&bar[XB_TMO], 1u); break; } }
    }
    nloc = mine > 0u ? mine : 1u; nx = cnt > 0u ? cnt : 1u;
}
__device__ __forceinline__ void xcd_barrier(const XcdBarrier& b) {
    asm volatile("s_waitcnt vmcnt(0)" ::: "memory");
    __syncthreads();
    if (threadIdx.x == 0) {
        unsigned* bar = b.bar;
        __builtin_amdgcn_s_waitcnt(0);
        unsigned nloc = b.st[0], nx = b.st[1];
        if (nloc == 0u) { xcd_barrier_complete(bar, b.x, nloc, nx); b.st[0] = nloc; b.st[1] = nx; }
        const unsigned old = xb_add(&bar[XB_XSUB(b.x)], 1u);
        const unsigned gen = old / nloc;
        if (old + 1u == (gen + 1u) * nloc) {
            __builtin_amdgcn_fence(__ATOMIC_RELEASE, "agent");
            asm volatile("s_waitcnt vmcnt(0)" ::: "memory");
            const unsigned og = xb_add(&bar[XB_TOP], 1u);
            const unsigned tg = og / nx;
            if (og + 1u == (tg + 1u) * nx) xb_add(&bar[XB_TOPGEN], 1u);
            else XB_SPIN(xb_ld(&bar[XB_TOPGEN]) == tg, bar);
            __builtin_amdgcn_fence(__ATOMIC_ACQUIRE, "agent");
            xb_add(&bar[XB_XGEN(b.x)], 1u);
            asm volatile("s_waitcnt vmcnt(0)" ::: "memory");
        } else {
            XB_SPIN(xb_ld(&bar[XB_XGEN(b.x)]) == gen, bar);
            __builtin_amdgcn_fence(__ATOMIC_ACQUIRE, "agent");
            asm volatile("s_waitcnt vmcnt(0)" ::: "memory");
        }
    }
    __syncthreads();
}

constexpr int T_ = 16384, D_ = 1024, S_ = 2048;
constexpr int DFF = 2816, DFE = 3584, DRNN = 1280;
constexpr int NSLOT = 34816;
constexpr float ALPHA = 1.6817928305074290f;
constexpr float LN_EPS = 1e-5f;
constexpr int NTHREADS = 512;
constexpr int STAGE_BYTES = 131072;
constexpr int MISC_OFF = STAGE_BYTES;
constexpr int MISC_BYTES = 8192;
constexpr int LDS_BYTES = STAGE_BYTES + MISC_BYTES;

constexpr size_t al256(size_t x) { return (x + 255) & ~(size_t)255; }
constexpr size_t OFF_CTL = 0, CTL_BYTES = 65536;
constexpr size_t OFF_WA_IN  = OFF_CTL + CTL_BYTES;
constexpr size_t OFF_WA_OUT = OFF_WA_IN  + (size_t)3072 * 1024 * 2;
constexpr size_t OFF_WB_RKV = OFF_WA_OUT + (size_t)1024 * 1024 * 2;
constexpr size_t OFF_WB_L1  = OFF_WB_RKV + (size_t)3 * 1024 * 1024 * 2;
constexpr size_t OFF_WB_L2  = OFF_WB_L1  + (size_t)3 * 256 * 1024 * 2;
constexpr size_t OFF_WB_O   = OFF_WB_L2  + (size_t)3 * 1024 * 256 * 2;
constexpr size_t OFF_WC_IN  = OFF_WB_O   + (size_t)1024 * 1024 * 2;
constexpr size_t OFF_WC_G   = OFF_WC_IN  + (size_t)2560 * 1024 * 2;
constexpr size_t OFF_WC_OUT = OFF_WC_G   + (size_t)5 * 512 * 256 * 2;
constexpr size_t OFF_WD_IN  = OFF_WC_OUT + (size_t)1024 * 1280 * 2;
constexpr size_t OFF_WD_O   = OFF_WD_IN  + (size_t)6144 * 1024 * 2;
constexpr size_t OFF_WF_GU  = OFF_WD_O   + (size_t)1024 * 2048 * 2;
constexpr size_t OFF_WF_DN  = OFF_WF_GU  + (size_t)2 * 5632 * 1024 * 2;
constexpr size_t OFF_WM_GU  = OFF_WF_DN  + (size_t)2 * 1024 * 2816 * 2;
constexpr size_t OFF_WM_DN  = OFF_WM_GU  + (size_t)16 * 7168 * 1024 * 2;
constexpr size_t OFF_ROT    = OFF_WM_DN  + (size_t)16 * 1024 * 3584 * 2;
constexpr size_t OFF_X      = OFF_ROT    + (size_t)2 * T_ * 128 * 4;
constexpr size_t OFF_XB     = OFF_X      + (size_t)T_ * D_ * 4;
constexpr size_t OFF_PRE    = OFF_XB     + (size_t)T_ * D_ * 2;
constexpr size_t OFF_ROUTE  = OFF_PRE    + (size_t)T_ * D_ * 4;
constexpr size_t OFF_ARENA  = OFF_ROUTE  + (size_t)T_ * 8 * 4;
constexpr size_t A0_BCV = OFF_ARENA;
constexpr size_t A0_YA  = A0_BCV + (size_t)T_ * 3072 * 2;
constexpr size_t AF_H   = OFF_ARENA;
constexpr size_t A1_XMIX = OFF_ARENA;
constexpr size_t A1_RKV  = A1_XMIX + (size_t)6 * T_ * D_ * 2;
constexpr size_t A1_L1   = A1_RKV  + (size_t)3 * T_ * D_ * 2;
constexpr size_t A1_O3   = A1_L1   + (size_t)3 * T_ * 256 * 2;
constexpr size_t A1_Y    = A1_O3   + (size_t)3 * T_ * D_ * 4;
constexpr size_t A1_YB   = A1_Y    + (size_t)T_ * D_ * 4;
constexpr size_t A1_END  = A1_YB   + (size_t)T_ * D_ * 2;
constexpr size_t AM_XG = OFF_ARENA;
constexpr size_t AM_H  = AM_XG + (size_t)NSLOT * D_ * 2;
constexpr size_t AM_O  = AM_H  + (size_t)NSLOT * DFE * 2;
constexpr size_t A2_GG = OFF_ARENA;
constexpr size_t A2_UU = A2_GG + (size_t)T_ * DRNN * 2;
constexpr size_t A2_UC = A2_UU + (size_t)T_ * DRNN * 2;
constexpr size_t A2_AT = A2_UC + (size_t)T_ * DRNN * 2;
constexpr size_t A2_BT = A2_AT + (size_t)T_ * DRNN * 4;
constexpr size_t A2_YC = A2_BT + (size_t)T_ * DRNN * 4;
constexpr size_t A3_QR = OFF_ARENA;
constexpr size_t A3_KR = A3_QR + (size_t)T_ * D_ * 2;
constexpr size_t A3_GS = A3_KR + (size_t)T_ * D_ * 2;
constexpr size_t A3_VT = A3_GS + (size_t)T_ * 2048 * 2;
constexpr size_t A3_SC = A3_VT + (size_t)T_ * 2048 * 2;
constexpr size_t A3_Y  = A3_SC + (size_t)32 * 2048 * 2048 * 2;
constexpr size_t A3_YD = A3_Y  + (size_t)T_ * 2048 * 2;
constexpr size_t A3_END = A3_YD + (size_t)T_ * 2048 * 2;
constexpr size_t WS_NEED = (A1_END > A3_END ? A1_END : A3_END);
constexpr int CTL_MOE_CNT = 4096;

__device__ __forceinline__ int rfl(int v) { return __builtin_amdgcn_readfirstlane(v); }
__device__ __forceinline__ const char* rfl_ptr(const char* p) {
    const unsigned long long v = (unsigned long long)p;
    const unsigned lo = (unsigned)rfl((int)(unsigned)v), hi = (unsigned)rfl((int)(unsigned)(v >> 32));
    return (const char*)(((unsigned long long)hi << 32) | lo);
}
__device__ __forceinline__ unsigned pk_bf16(float lo, float hi) { unsigned r; asm volatile("v_cvt_pk_bf16_f32 %0, %1, %2" : "=v"(r) : "v"(lo), "v"(hi)); return r; }
__device__ __forceinline__ float bf_lo(unsigned w) { return __uint_as_float(w << 16); }
__device__ __forceinline__ float bf_hi(unsigned w) { return __uint_as_float(w & 0xffff0000u); }
__device__ __forceinline__ float bf1(bf16_t h) { return __uint_as_float(((unsigned)h) << 16); }
__device__ __forceinline__ float fsigmoid(float x) { return __builtin_amdgcn_rcpf(1.0f + __expf(-x)); }
__device__ __forceinline__ float fsilu(float x) { return x * fsigmoid(x); }
__device__ __forceinline__ float ftanh(float x) { const float t = __expf(2.0f * x); return 1.0f - 2.0f * __builtin_amdgcn_rcpf(t + 1.0f); }
__device__ __forceinline__ float fgelu_tanh(float x) { const float u = 0.7978845608028654f * (x + 0.044715f * x * x * x); return 0.5f * x * (1.0f + ftanh(u)); }
__device__ __forceinline__ float wave_sum(float v) {
#pragma unroll
    for (int o = 32; o >= 1; o >>= 1) v += __shfl_xor(v, o);
    return v;
}
template <int CTRL> __device__ __forceinline__ float dpp_mov(float x) { return __int_as_float(__builtin_amdgcn_update_dpp(0, __float_as_int(x), CTRL, 0xf, 0xf, true)); }
__device__ __forceinline__ float allreduce16(float x) {
    x += dpp_mov<0xB1>(x);
    x += dpp_mov<0x4E>(x);
    x += dpp_mov<0x141>(x);
    x += dpp_mov<0x140>(x);
    return x;
}

namespace pg8 {
constexpr int BM = 256, BK = 64, HALF = 128, HTB = HALF * BK * 2;
__device__ __forceinline__ int lds_byte(int r, int c) { const int st = (r >> 4) * 2 + (c >> 5), rr = r & 15, cc = c & 31, ob = rr * 64 + cc * 2; return st * 1024 + (ob ^ (((ob >> 9) & 1) << 5)); }
__device__ __forceinline__ void stage_rc(int b, int& R, int& C) { const int st = b / 1024, sb = b % 1024, swz = sb ^ (((sb >> 9) & 1) << 5); R = (st >> 1) * 16 + swz / 64; C = (st & 1) * 32 + (swz % 64) / 2; }
__device__ __forceinline__ int perm32(int rho) { const int n = rho >> 4, i = rho & 15; return 8 * (i >> 2) + 4 * n + (i & 3); }

struct Unit { const char* a; const char* b; int nt; int pm, pn, job, ro; };

template <class Epi, class Sched>
__device__ __forceinline__ void gemm_phase(LAS unsigned char* lds, const int lda, const int ldb, const Sched& S, const Epi& E) {
    const int tid = threadIdx.x, wid = rfl(tid >> 6), lane = tid & 63, wr = wid >> 2, wc = wid & 3, fr = lane & 15, fq = lane >> 4;
    unsigned voffA[2], voffB[2];
#pragma unroll
    for (int i = 0; i < 2; ++i) { int R, C; stage_rc(tid * 16 + i * 8192, R, C); const int Rb = (R & ~31) + perm32(R & 31);
        voffA[i] = (unsigned)(R * lda + C) * 2u; voffB[i] = (unsigned)(Rb * ldb + C) * 2u; }
    const size_t kstep = (size_t)(BK * 2);
    const size_t hstepA = (size_t)HALF * lda * 2, hstepB = (size_t)HALF * ldb * 2;
    const unsigned ldsw = (unsigned)wid * 1024u;
    const int aoff = lds_byte(wr * 64 + fr, fq * 8), boff = lds_byte(wc * 32 + fr, fq * 8);
#define PG8_SA(b, h) (((b) * 2 + (h)) * HTB)
#define PG8_SB(b, h) ((4 + (b) * 2 + (h)) * HTB)
#define PG8_STAGE(bufoff, gbase, voff) do { _Pragma("unroll") for (int _i = 0; _i < 2; ++_i) \
        __builtin_amdgcn_global_load_lds((const unsigned*)((const char*)(gbase) + (voff)[_i]), (LAS unsigned*)(lds + (bufoff) + ldsw + _i * 8192), 16, 0, 0); } while (0)
#define PG8_LDA(dst, b, h) do { _Pragma("unroll") for (int m = 0; m < 4; ++m) _Pragma("unroll") for (int k = 0; k < 2; ++k) dst[m][k] = *(const LAS bf16x8*)(lds + PG8_SA(b, h) + aoff + m * 2048 + k * 1024); } while (0)
#define PG8_LDB(dst, b, h) do { _Pragma("unroll") for (int n = 0; n < 2; ++n) _Pragma("unroll") for (int k = 0; k < 2; ++k) dst[n][k] = *(const LAS bf16x8*)(lds + PG8_SB(b, h) + boff + n * 2048 + k * 1024); } while (0)
#define PG8_MMA(ai, bj, At, Bt) do { __builtin_amdgcn_s_setprio(1); _Pragma("unroll") for (int m = 0; m < 4; ++m) _Pragma("unroll") for (int n = 0; n < 2; ++n) _Pragma("unroll") for (int k = 0; k < 2; ++k) \
        acc[ai][bj][m][n] = __builtin_amdgcn_mfma_f32_16x16x32_bf16(Bt[n][k], At[m][k], acc[ai][bj][m][n], 0, 0, 0); __builtin_amdgcn_s_setprio(0); } while (0)
#define PG8_WAIT_V(n) asm volatile("s_waitcnt vmcnt(" #n ")" ::: "memory")
#define PG8_WAIT_L(n) asm volatile("s_waitcnt lgkmcnt(" #n ")" ::: "memory")
#define PG8_BAR __builtin_amdgcn_s_barrier()
#define PG8_SCHED __builtin_amdgcn_sched_barrier(0)
    Unit cur, nxt; int ui = 0;
    if (!S.next(0, cur)) return;
    f32x4 acc[2][2][4][2];
#pragma unroll
    for (int a = 0; a < 2; ++a)
#pragma unroll
        for (int b = 0; b < 2; ++b)
#pragma unroll
            for (int m = 0; m < 4; ++m)
#pragma unroll
                for (int n = 0; n < 2; ++n) acc[a][b][m][n] = (f32x4){0.f, 0.f, 0.f, 0.f};
    bf16x8 At[4][2], B0[2][2], B1[2][2];
    const char* cA = cur.a; const char* cB = cur.b;
    PG8_STAGE(PG8_SB(0, 0), cB, voffB); PG8_STAGE(PG8_SA(0, 0), cA, voffA); PG8_STAGE(PG8_SB(0, 1), cB + hstepB, voffB); PG8_STAGE(PG8_SA(0, 1), cA + hstepA, voffA);
    if (wr == 1) PG8_BAR;
    PG8_WAIT_V(4); PG8_BAR;
    PG8_STAGE(PG8_SB(1, 0), cB + kstep, voffB); PG8_STAGE(PG8_SA(1, 0), cA + kstep, voffA); PG8_STAGE(PG8_SB(1, 1), cB + hstepB + kstep, voffB);
    PG8_WAIT_V(6); PG8_BAR;
    for (;;) {
        const bool has_next = S.next(ui + 1, nxt);
        const char* nA = has_next ? nxt.a : cA; const char* nB = has_next ? nxt.b : cB;
        const int nt = cur.nt;
        for (int t = 0; t < nt; t += 2) {
            const bool last = (t == nt - 2);
            const char* a1 = cA + (size_t)(t + 1) * kstep;
            const char* a2 = last ? nA : cA + (size_t)(t + 2) * kstep; const char* b2 = last ? nB : cB + (size_t)(t + 2) * kstep;
            const char* a3 = a2 + kstep; const char* b3 = b2 + kstep;
            PG8_LDB(B0, 0, 0); PG8_SCHED; PG8_LDA(At, 0, 0); PG8_STAGE(PG8_SA(1, 1), a1 + hstepA, voffA);
            PG8_WAIT_L(8); PG8_BAR; PG8_WAIT_L(0); PG8_MMA(0, 0, At, B0); PG8_BAR; PG8_SCHED;
            PG8_LDB(B1, 0, 1); PG8_STAGE(PG8_SB(0, 0), b2, voffB);
            PG8_BAR; PG8_WAIT_L(0); PG8_MMA(0, 1, At, B1); PG8_BAR;
            PG8_LDA(At, 0, 1); PG8_STAGE(PG8_SA(0, 0), a2, voffA);
            PG8_BAR; PG8_WAIT_L(0); PG8_MMA(1, 0, At, B0); PG8_BAR; PG8_SCHED;
            PG8_STAGE(PG8_SB(0, 1), b2 + hstepB, voffB);
            PG8_WAIT_V(6); PG8_BAR; PG8_MMA(1, 1, At, B1); PG8_BAR;
            PG8_LDB(B0, 1, 0); PG8_SCHED; PG8_LDA(At, 1, 0); PG8_STAGE(PG8_SA(0, 1), a2 + hstepA, voffA);
            PG8_WAIT_L(8); PG8_BAR; PG8_WAIT_L(0); PG8_MMA(0, 0, At, B0); PG8_BAR; PG8_SCHED;
            PG8_LDB(B1, 1, 1); PG8_STAGE(PG8_SB(1, 0), b3, voffB);
            PG8_BAR; PG8_WAIT_L(0); PG8_MMA(0, 1, At, B1); PG8_BAR;
            PG8_LDA(At, 1, 1); PG8_STAGE(PG8_SA(1, 0), a3, voffA);
            PG8_BAR; PG8_WAIT_L(0); PG8_MMA(1, 0, At, B0); PG8_BAR; PG8_SCHED;
            PG8_STAGE(PG8_SB(1, 1), b3 + hstepB, voffB);
            PG8_WAIT_V(6); PG8_BAR; PG8_MMA(1, 1, At, B1); PG8_BAR;
        }
#pragma unroll
        for (int ai = 0; ai < 2; ++ai)
#pragma unroll
            for (int m = 0; m < 4; ++m) E(cur, ai * HALF + wr * 64 + m * 16 + fr, wc * 32 + 8 * fq, acc[ai][0][m][0], acc[ai][0][m][1], acc[ai][1][m][0], acc[ai][1][m][1]);
        if (!has_next) break;
#pragma unroll
        for (int a = 0; a < 2; ++a)
#pragma unroll
            for (int b = 0; b < 2; ++b)
#pragma unroll
                for (int m = 0; m < 4; ++m)
#pragma unroll
                    for (int n = 0; n < 2; ++n) acc[a][b][m][n] = (f32x4){0.f, 0.f, 0.f, 0.f};
        cur = nxt; cA = nA; cB = nB; ++ui;
    }
    PG8_WAIT_V(0);
    if (wr == 0) PG8_BAR;
    PG8_BAR;
#undef PG8_SA
#undef PG8_SB
#undef PG8_STAGE
#undef PG8_LDA
#undef PG8_LDB
#undef PG8_MMA
#undef PG8_WAIT_V
#undef PG8_WAIT_L
#undef PG8_BAR
#undef PG8_SCHED
}

__device__ __forceinline__ void tile_map(int L, int nM, int nN, int& pm, int& pn) {
    const int nwg = nM * nN, q = nwg / 8, r = nwg % 8, xcd = L % 8, off = L / 8;
    const int wgid = (xcd < r ? xcd * (q + 1) : r * (q + 1) + (xcd - r) * q) + off;
    const int nig = 8 * nN, gid = wgid / nig, fm = gid * 8, gsz = (nM - fm) < 8 ? (nM - fm) : 8;
    pm = fm + ((wgid % nig) % gsz); pn = (wgid % nig) / gsz;
}

constexpr int JOBW = 10;
struct JobSched {
    const LAS int* tab; int nj, total, G, c, lda, ldb;
    __device__ __forceinline__ bool next(int i, Unit& u) const {
        const long Lg = (long)i * G + c; if (Lg >= total) return false;
        const int L = (int)Lg; int j = 0;
        while (j + 1 < nj && L >= tab[(j + 1) * JOBW + 7]) ++j;
        const LAS int* J = tab + j * JOBW;
        const unsigned long long ja = ((unsigned long long)(unsigned)J[1] << 32) | (unsigned)J[0], jb = ((unsigned long long)(unsigned)J[3] << 32) | (unsigned)J[2];
        int pm, pn; tile_map(L - J[7], J[4], J[5], pm, pn);
        pm = rfl(pm); pn = rfl(pn);
        u.a = rfl_ptr((const char*)ja + (size_t)pm * 256 * lda * 2);
        u.b = rfl_ptr((const char*)jb + (size_t)pn * 256 * ldb * 2);
        u.nt = rfl(J[6]); u.pm = pm; u.pn = pn; u.job = rfl(j); u.ro = rfl(J[8]);
        return true;
    }
};
}
using pg8::Unit;

struct Params { const float* in[43]; float* out; unsigned char* ws; int ph_lo, ph_hi; };

struct Ctx {
    const Params* p; unsigned char* ws; LAS unsigned char* lds; int tid, lane, wave, G, bid;
    __device__ __forceinline__ const float* in(int i) const { return p->in[i]; }
    template <class Tp> __device__ __forceinline__ Tp* w(size_t off) const { return (Tp*)(ws + off); }
};

__device__ __forceinline__ void store8_bf16(bf16_t* p, const f32x4& a, const f32x4& b) {
    u32x4 w; w.x = pk_bf16(a[0], a[1]); w.y = pk_bf16(a[2], a[3]); w.z = pk_bf16(b[0], b[1]); w.w = pk_bf16(b[2], b[3]);
    *(u32x4*)p = w;
}

__device__ __forceinline__ void set_job(const Ctx& X, int j, const void* a, const void* b, int nM, int nN, int nt, int base, int ro) {
    LAS int* J = (LAS int*)(X.lds + MISC_OFF + 64) + j * pg8::JOBW;
    const unsigned long long ua = (unsigned long long)a, ub = (unsigned long long)b;
    J[0] = (int)(unsigned)ua; J[1] = (int)(unsigned)(ua >> 32); J[2] = (int)(unsigned)ub; J[3] = (int)(unsigned)(ub >> 32);
    J[4] = nM; J[5] = nN; J[6] = nt; J[7] = base; J[8] = ro; J[9] = 0;
}
__device__ __forceinline__ pg8::JobSched make_sched(const Ctx& X, int nj, int total, int lda, int ldb) {
    pg8::JobSched S; S.tab = (const LAS int*)(X.lds + MISC_OFF + 64); S.nj = nj; S.total = total; S.G = X.G; S.c = X.bid; S.lda = lda; S.ldb = ldb; return S;
}

struct EpiStoreBf16 {
    bf16_t* O; int ldo;
    __device__ __forceinline__ void operator()(const Unit& u, int r, int c, const f32x4& l0, const f32x4& l1, const f32x4& h0, const f32x4& h1) const {
        bf16_t* q = O + (size_t)(u.ro + u.pm * 256 + r) * ldo + u.pn * 256 + c;
        store8_bf16(q, l0, l1); store8_bf16(q + 128, h0, h1);
    }
};
struct EpiResid {
    const float* x; float* pre;
    __device__ __forceinline__ void operator()(const Unit& u, int r, int c, const f32x4& l0, const f32x4& l1, const f32x4& h0, const f32x4& h1) const {
        const size_t o = (size_t)(u.pm * 256 + r) * D_ + u.pn * 256 + c;
        const f32x4 x0 = *(const f32x4*)(x + o), x1 = *(const f32x4*)(x + o + 4), x2 = *(const f32x4*)(x + o + 128), x3 = *(const f32x4*)(x + o + 132);
        *(f32x4*)(pre + o) = x0 * ALPHA + l0; *(f32x4*)(pre + o + 4) = x1 * ALPHA + l1;
        *(f32x4*)(pre + o + 128) = x2 * ALPHA + h0; *(f32x4*)(pre + o + 132) = x3 * ALPHA + h1;
    }
};
struct EpiSwiglu {
    bf16_t* H; int ldh;
    __device__ __forceinline__ void operator()(const Unit& u, int r, int c, const f32x4& l0, const f32x4& l1, const f32x4& h0, const f32x4& h1) const {
        f32x4 a, b;
#pragma unroll
        for (int j = 0; j < 4; ++j) { a[j] = fsilu(l0[j]) * h0[j]; b[j] = fsilu(l1[j]) * h1[j]; }
        store8_bf16(H + (size_t)(u.ro + u.pm * 256 + r) * ldh + u.pn * 128 + c, a, b);
    }
};
struct EpiRwkv1 {
    bf16_t* rkv; bf16_t* l1;
    __device__ __forceinline__ void operator()(const Unit& u, int r, int c, const f32x4& l0, const f32x4& l1v, const f32x4& h0, const f32x4& h1) const {
        const int row = u.pm * 256 + r;
        if (u.job < 3) { bf16_t* q = rkv + (size_t)u.job * T_ * D_ + (size_t)row * D_ + u.pn * 256 + c; store8_bf16(q, l0, l1v); store8_bf16(q + 128, h0, h1); }
        else {
            f32x4 a = l0, b = l1v, cc = h0, d = h1;
            if (u.job == 3) {
#pragma unroll
                for (int j = 0; j < 4; ++j) { a[j] = ftanh(a[j]); b[j] = ftanh(b[j]); cc[j] = ftanh(cc[j]); d[j] = ftanh(d[j]); } }
            else if (u.job == 5) {
#pragma unroll
                for (int j = 0; j < 4; ++j) { a[j] = fsigmoid(a[j]); b[j] = fsigmoid(b[j]); cc[j] = fsigmoid(cc[j]); d[j] = fsigmoid(d[j]); } }
            bf16_t* q = l1 + (size_t)(u.job - 3) * T_ * 256 + (size_t)row * 256 + c; store8_bf16(q, a, b); store8_bf16(q + 128, cc, d);
        }
    }
};
struct EpiRwkv2 {
    float* o3; const float* w0; const float* a0;
    __device__ __forceinline__ void one(const Unit& u, float* q, int col, const f32x4& v) const {
        f32x4 o;
        if (u.job == 0) { const f32x4 bv = *(const f32x4*)(w0 + col);
#pragma unroll
            for (int j = 0; j < 4; ++j) o[j] = __expf(-0.6065306597126334f * fsigmoid(bv[j] + v[j])); }
        else if (u.job == 1) { const f32x4 bv = *(const f32x4*)(a0 + col);
#pragma unroll
            for (int j = 0; j < 4; ++j) o[j] = fsigmoid(bv[j] + v[j]); }
        else o = v;
        *(f32x4*)q = o;
    }
    __device__ __forceinline__ void operator()(const Unit& u, int r, int c, const f32x4& l0, const f32x4& l1, const f32x4& h0, const f32x4& h1) const {
        const int col = u.pn * 256 + c; float* q = o3 + (size_t)u.job * T_ * D_ + (size_t)(u.pm * 256 + r) * D_ + col;
        one(u, q, col, l0); one(u, q + 4, col + 4, l1); one(u, q + 128, col + 128, h0); one(u, q + 132, col + 132, h1);
    }
};
struct EpiGriffinIn {
    bf16_t* gg; bf16_t* uu;
    __device__ __forceinline__ void operator()(const Unit& u, int r, int c, const f32x4& l0, const f32x4& l1, const f32x4& h0, const f32x4& h1) const {
        const int row = u.pm * 256 + r;
        if (u.pn < 5) { f32x4 a, b, cc, d;
#pragma unroll
            for (int j = 0; j < 4; ++j) { a[j] = fgelu_tanh(l0[j]); b[j] = fgelu_tanh(l1[j]); cc[j] = fgelu_tanh(h0[j]); d[j] = fgelu_tanh(h1[j]); }
            bf16_t* q = gg + (size_t)row * DRNN + u.pn * 256 + c; store8_bf16(q, a, b); store8_bf16(q + 128, cc, d); }
        else { bf16_t* q = uu + (size_t)row * DRNN + (u.pn - 5) * 256 + c; store8_bf16(q, l0, l1); store8_bf16(q + 128, h0, h1); }
    }
};
struct EpiGates {
    const bf16_t* uc; const float* b_ga; const float* b_gx; const float* lam; const int* pos; float* at; float* bt;
    __device__ __forceinline__ void four(int row, int ch, bool reset, const f32x4& lo, const f32x4& hi) const {
        const f32x4 ba = *(const f32x4*)(b_ga + ch), bx = *(const f32x4*)(b_gx + ch), lm = *(const f32x4*)(lam + ch);
        const u32x2 uw = *(const u32x2*)(uc + (size_t)row * DRNN + ch);
        const float uv[4] = {bf_lo(uw.x), bf_hi(uw.x), bf_lo(uw.y), bf_hi(uw.y)};
        f32x4 a, b;
#pragma unroll
        for (int j = 0; j < 4; ++j) {
            const float rg = fsigmoid(lo[j] + ba[j]), ig = fsigmoid(hi[j] + bx[j]);
            const float sp = log1pf(__expf(-lm[j]));
            const float la = -8.0f * rg * sp;
            float av = __expf(la), mult = sqrtf(-expm1f(2.0f * la));
            if (reset) { av = 0.f; mult = 1.f; }
            a[j] = av; b[j] = mult * (ig * uv[j]);
        }
        *(f32x4*)(at + (size_t)row * DRNN + ch) = a; *(f32x4*)(bt + (size_t)row * DRNN + ch) = b;
    }
    __device__ __forceinline__ void operator()(const Unit& u, int r, int c, const f32x4& l0, const f32x4& l1, const f32x4& h0, const f32x4& h1) const {
        const int row = u.pm * 256 + r, ch = u.job * 256 + u.pn * 128 + c; const bool reset = pos[row] == 0;
        four(row, ch, reset, l0, h0); four(row, ch + 4, reset, l1, h1);
    }
};
struct EpiRetIn {
    bf16_t* qr; bf16_t* kr; bf16_t* gs; bf16_t* vt; const float* rc; const float* rs;
    __device__ __forceinline__ void operator()(const Unit& u, int r, int c, const f32x4& l0, const f32x4& l1, const f32x4& h0, const f32x4& h1) const {
        const int row = u.pm * 256 + r;
        if (u.job < 2) {
            const f32x4 c0 = *(const f32x4*)(rc + (size_t)row * 128 + c), c1 = *(const f32x4*)(rc + (size_t)row * 128 + c + 4);
            const f32x4 s0 = *(const f32x4*)(rs + (size_t)row * 128 + c), s1 = *(const f32x4*)(rs + (size_t)row * 128 + c + 4);
            const float sc = u.job == 1 ? 0.0625f : 1.0f;
            const f32x4 a = (l0 * c0 - h0 * s0) * sc, b = (l1 * c1 - h1 * s1) * sc, cc = (l0 * s0 + h0 * c0) * sc, d = (l1 * s1 + h1 * c1) * sc;
            bf16_t* q = (u.job == 0 ? qr : kr) + (size_t)row * D_ + u.pn * 256 + c; store8_bf16(q, a, b); store8_bf16(q + 128, cc, d);
        } else if (u.job == 2) {
            f32x4 a, b, cc, d;
#pragma unroll
            for (int j = 0; j < 4; ++j) { a[j] = fsilu(l0[j]); b[j] = fsilu(l1[j]); cc[j] = fsilu(h0[j]); d[j] = fsilu(h1[j]); }
            bf16_t* q = gs + (size_t)row * 2048 + u.pn * 256 + c; store8_bf16(q, a, b); store8_bf16(q + 128, cc, d);
        } else { bf16_t* q = vt + (size_t)row * T_ + u.pn * 256 + c; store8_bf16(q, l0, l1); store8_bf16(q + 128, h0, h1); }
    }
};
struct EpiScores {
    bf16_t* sc;
    __device__ __forceinline__ f32x4 four(int i, int j0, float l2g, const f32x4& v) const {
        f32x4 o;
#pragma unroll
        for (int jj = 0; jj < 4; ++jj) { const int j = j0 + jj; const int d = i > j ? i - j : j - i;
            const float w = ((i >> 6) >= (j >> 6)) ? exp2f((float)d * l2g) : 0.f; o[jj] = v[jj] * w; }
        return o;
    }
    __device__ __forceinline__ void operator()(const Unit& u, int r, int c, const f32x4& l0, const f32x4& l1, const f32x4& h0, const f32x4& h1) const {
        const int h = u.job & 3, i = u.pm * 256 + r, j0 = u.pn * 256 + c;
        const float l2g = __log2f(1.0f - exp2f(-5.0f - (float)h));
        const f32x4 a = four(i, j0, l2g, l0), b = four(i, j0 + 4, l2g, l1), cc = four(i, j0 + 128, l2g, h0), d = four(i, j0 + 132, l2g, h1);
        bf16_t* q = sc + (size_t)u.job * 2048 * 2048 + (size_t)i * 2048 + j0; store8_bf16(q, a, b); store8_bf16(q + 128, cc, d);
    }
};
struct EpiRetOut {
    bf16_t* y;
    __device__ __forceinline__ void operator()(const Unit& u, int r, int c, const f32x4& l0, const f32x4& l1, const f32x4& h0, const f32x4& h1) const {
        const int b = u.job >> 2, h = u.job & 3;
        bf16_t* q = y + (size_t)(b * 2048 + u.pm * 256 + r) * 2048 + h * 512 + u.pn * 256 + c; store8_bf16(q, l0, l1); store8_bf16(q + 128, h0, h1);
    }
};
struct ScoreSched {
    const char* qr; const char* kr; int G, c;
    __device__ __forceinline__ bool next(int i, Unit& u) const {
        const long Lg = (long)i * G + c; if (Lg >= 32 * 36) return false;
        const int L = (int)Lg, bh = L / 36; int tri = L % 36, pm = 0; while (tri >= pm + 1) { tri -= pm + 1; ++pm; }
        const int b = bh >> 2, h = bh & 3;
        u.a = qr + ((size_t)(b * 2048 + pm * 256) * D_ + h * 256) * 2; u.b = kr + ((size_t)(b * 2048 + tri * 256) * D_ + h * 256) * 2;
        u.nt = 4; u.pm = pm; u.pn = tri; u.job = bh; u.ro = 0; return true;
    }
};
struct RetOutSched {
    const char* sc; const char* vt; int G, c;
    __device__ __forceinline__ bool next(int i, Unit& u) const {
        const long Lg = (long)i * G + c; if (Lg >= 512) return false;
        const int L = (int)Lg, round = L / 256, cc = L % 256, bh = cc / 8, pn = (cc / 4) % 2, pp = cc % 4, pm = round == 0 ? 7 - pp : pp;
        const int b = bh >> 2, h = bh & 3;
        u.a = sc + ((size_t)bh * 2048 * 2048 + (size_t)pm * 256 * 2048) * 2; u.b = vt + ((size_t)(h * 512 + pn * 256) * T_ + b * 2048) * 2;
        u.nt = 4 * (pm + 1); u.pm = pm; u.pn = pn; u.job = bh; u.ro = 0; return true;
    }
};

struct CvtTask { unsigned long long src, dst; int ld_src, Ksrc, Nsrc, koff, ld_dst, Nd, Kd, swF, tbase, ntiles, p0, p1; };
constexpr int NCVT = 72;
__device__ __forceinline__ void make_task(const Ctx& X, int i, CvtTask& t) {
    const float* src = nullptr; size_t dst = 0; int ld_src = 1024, Ksrc = 1024, Nsrc = 1024, koff = 0, ld_dst = 1024, Nd = 1024, Kd = 1024, swF = 0;
    if (i == 0) { src = X.in(6); dst = OFF_WA_IN; ld_src = 3072; Nsrc = 3072; Nd = 3072; }
    else if (i == 1) { src = X.in(8); dst = OFF_WA_OUT; }
    else if (i < 5) { const int j = i - 2; src = X.in(10 + j); dst = OFF_WB_RKV + (size_t)j * 1024 * 1024 * 2; }
    else if (i < 8) { const int j = i - 5; src = X.in(j == 0 ? 14 : (j == 1 ? 17 : 19)); Nsrc = j == 2 ? 160 : 64; ld_src = Nsrc; Nd = 256; dst = OFF_WB_L1 + (size_t)j * 256 * 1024 * 2; }
    else if (i < 11) { const int j = i - 8; src = X.in(j == 0 ? 15 : (j == 1 ? 18 : 20)); Ksrc = j == 2 ? 160 : 64; Kd = 256; ld_dst = 256; dst = OFF_WB_L2 + (size_t)j * 1024 * 256 * 2; }
    else if (i == 11) { src = X.in(26); dst = OFF_WB_O; }
    else if (i == 12) { src = X.in(27); dst = OFF_WC_IN; ld_src = 2560; Nsrc = 2560; Nd = 2560; }
    else if (i < 33) { const int idx = i - 13, gp = idx / 4, q = (idx / 2) % 2, hs = idx % 2;
        src = X.in(hs ? 32 : 30) + (size_t)(2 * gp + q) * 128 * 128; ld_src = 128; Ksrc = 128; Nsrc = 128; koff = 128 * q;
        dst = OFF_WC_G + ((size_t)(gp * 512 + 256 * q + 128 * hs) * 256) * 2; ld_dst = 256; Nd = 128; Kd = 256; }
    else if (i == 33) { src = X.in(35); dst = OFF_WC_OUT; Ksrc = 1280; Kd = 1280; ld_dst = 1280; }
    else if (i == 34) { src = X.in(36); dst = OFF_WD_IN; ld_src = 6144; Nsrc = 6144; Nd = 6144; }
    else if (i == 35) { src = X.in(37); dst = OFF_WD_O; Ksrc = 2048; Kd = 2048; ld_dst = 2048; }
    else if (i < 38) { const int l = i - 36; src = X.in(38) + (size_t)l * 1024 * 5632; ld_src = 5632; Nsrc = 5632; Nd = 5632; swF = DFF; dst = OFF_WF_GU + (size_t)l * 5632 * 1024 * 2; }
    else if (i < 40) { const int l = i - 38; src = X.in(39) + (size_t)l * 2816 * 1024; Ksrc = 2816; Kd = 2816; ld_dst = 2816; dst = OFF_WF_DN + (size_t)l * 1024 * 2816 * 2; }
    else if (i < 56) { const int le = i - 40; src = X.in(41) + (size_t)le * 1024 * 7168; ld_src = 7168; Nsrc = 7168; Nd = 7168; swF = DFE; dst = OFF_WM_GU + (size_t)le * 7168 * 1024 * 2; }
    else { const int le = i - 56; src = X.in(42) + (size_t)le * 3584 * 1024; Ksrc = 3584; Kd = 3584; ld_dst = 3584; dst = OFF_WM_DN + (size_t)le * 1024 * 3584 * 2; }
    t.src = (unsigned long long)src; t.dst = (unsigned long long)(X.ws + dst); t.ld_src = ld_src; t.Ksrc = Ksrc; t.Nsrc = Nsrc; t.koff = koff; t.ld_dst = ld_dst; t.Nd = Nd; t.Kd = Kd; t.swF = swF;
    t.ntiles = (Nd / 32) * (Kd / 64); t.tbase = 0; t.p0 = 0; t.p1 = 0;
}

__device__ __forceinline__ void ph_prologue(const Ctx& X) {
    LAS int* tasks = (LAS int*)(X.lds + MISC_OFF + 1024);
    LAS int* total_p = (LAS int*)(X.lds + MISC_OFF + 512);
    if (X.tid < NCVT) { CvtTask t; make_task(X, X.tid, t); LAS int* q = tasks + X.tid * 16;
        q[0] = (int)(unsigned)t.src; q[1] = (int)(unsigned)(t.src >> 32); q[2] = (int)(unsigned)t.dst; q[3] = (int)(unsigned)(t.dst >> 32);
        q[4] = t.ld_src; q[5] = t.Ksrc; q[6] = t.Nsrc; q[7] = t.koff; q[8] = t.ld_dst; q[9] = t.Nd; q[10] = t.Kd; q[11] = t.swF; q[12] = 0; q[13] = t.ntiles; }
    __syncthreads();
    if (X.tid == 0) { int acc = 0; for (int i = 0; i < NCVT; ++i) { tasks[i * 16 + 12] = acc; acc += tasks[i * 16 + 13]; } *total_p = acc; }
    __syncthreads();
    const int total = *total_p;
    {
        LAS unsigned char* tl = X.lds + X.wave * 4608;
        const int sub = X.lane >> 3, q4 = X.lane & 7;
        int ti = 0;
        for (int id = X.bid * 8 + X.wave; id < total; id += X.G * 8) {
            while (ti + 1 < NCVT && id >= tasks[(ti + 1) * 16 + 12]) ++ti;
            CvtTask t; { const LAS int* q = tasks + ti * 16;
                t.src = ((unsigned long long)(unsigned)q[1] << 32) | (unsigned)q[0]; t.dst = ((unsigned long long)(unsigned)q[3] << 32) | (unsigned)q[2];
                t.ld_src = q[4]; t.Ksrc = q[5]; t.Nsrc = q[6]; t.koff = q[7]; t.ld_dst = q[8]; t.Nd = q[9]; t.Kd = q[10]; t.swF = q[11]; t.tbase = q[12]; t.ntiles = q[13]; }
            const int loc = id - t.tbase, ntn = t.Nd / 32, tk = loc / ntn, tn = loc % ntn;
            const int nd0 = tn * 32;
            int n0 = nd0;
            if (t.swF) { const int pp = nd0 >> 8, hh = (nd0 >> 7) & 1, jj = nd0 & 127; n0 = hh * t.swF + pp * 128 + jj; }
            const bool nval = (n0 + q4 * 4) < t.Nsrc;
            const float* src = (const float*)t.src;
            f32x4 v0[4], v1[4];
#pragma unroll
            for (int s = 0; s < 4; ++s) {
                const int kd = tk * 64 + s * 16 + sub * 2, ks = kd - t.koff;
                const bool ok0 = nval && ks >= 0 && ks < t.Ksrc, ok1 = nval && (ks + 1) >= 0 && (ks + 1) < t.Ksrc;
                v0[s] = ok0 ? *(const f32x4*)(src + (size_t)ks * t.ld_src + n0 + q4 * 4) : (f32x4){0.f, 0.f, 0.f, 0.f};
                v1[s] = ok1 ? *(const f32x4*)(src + (size_t)(ks + 1) * t.ld_src + n0 + q4 * 4) : (f32x4){0.f, 0.f, 0.f, 0.f};
            }
#pragma unroll
            for (int s = 0; s < 4; ++s)
#pragma unroll
                for (int j = 0; j < 4; ++j) *(LAS unsigned*)(tl + (q4 * 4 + j) * 144 + (s * 16 + sub * 2) * 2) = pk_bf16(v0[s][j], v1[s][j]);
            asm volatile("s_waitcnt lgkmcnt(0)" ::: "memory"); __builtin_amdgcn_wave_barrier();
            bf16_t* dst = (bf16_t*)t.dst;
#pragma unroll
            for (int s = 0; s < 4; ++s) { const int n = s * 8 + sub;
                const u32x4 w = *(const LAS u32x4*)(tl + n * 144 + q4 * 16);
                *(u32x4*)(dst + (size_t)(nd0 + n) * t.ld_dst + tk * 64 + q4 * 8) = w; }
            asm volatile("s_waitcnt lgkmcnt(0)" ::: "memory"); __builtin_amdgcn_wave_barrier();
        }
    }
    const int gt = X.bid * NTHREADS + X.tid, gs = X.G * NTHREADS;
    { const float* x = X.in(0); bf16_t* xb = X.w<bf16_t>(OFF_XB);
      for (int i = gt; i < T_ * D_ / 8; i += gs) { const f32x4 a = *(const f32x4*)(x + (size_t)i * 8), b = *(const f32x4*)(x + (size_t)i * 8 + 4); store8_bf16(xb + (size_t)i * 8, a, b); } }
    { const int* pos = (const int*)X.in(1); float* rc = X.w<float>(OFF_ROT); float* rs = rc + (size_t)T_ * 128;
      for (int i = gt; i < T_ * 128; i += gs) { const int t = i >> 7, j = i & 127;
          const double fr = exp(-((double)j / 127.0) * 9.210340371976184);
          double rev = (double)pos[t] * fr * 0.15915494309189535; rev -= rint(rev);
          rc[i] = __builtin_amdgcn_cosf((float)rev); rs[i] = __builtin_amdgcn_sinf((float)rev); } }
}

template <bool MOE>
__device__ __forceinline__ void ph_ln(const Ctx& X, const float* pre, const float* g, const float* b, float* xo, bf16_t* xb, const float* xin, const bf16_t* om, const int* route) {
    const int c0 = X.lane * 4;
    f32x4 gv[4], bv[4];
#pragma unroll
    for (int i = 0; i < 4; ++i) { gv[i] = *(const f32x4*)(g + c0 + 256 * i); bv[i] = *(const f32x4*)(b + c0 + 256 * i); }
    for (int row = X.bid * 8 + X.wave; row < T_; row += X.G * 8) {
        f32x4 v[4];
        if (!MOE) {
#pragma unroll
            for (int i = 0; i < 4; ++i) v[i] = *(const f32x4*)(pre + (size_t)row * D_ + c0 + 256 * i);
        } else {
            const int s1 = route[row * 8 + 6], s2 = route[row * 8 + 7]; const float p1 = __int_as_float(route[row * 8 + 4]), p2 = __int_as_float(route[row * 8 + 5]);
#pragma unroll
            for (int i = 0; i < 4; ++i) { const f32x4 xv = *(const f32x4*)(xin + (size_t)row * D_ + c0 + 256 * i);
                const u32x2 w1 = *(const u32x2*)(om + (size_t)s1 * D_ + c0 + 256 * i), w2 = *(const u32x2*)(om + (size_t)s2 * D_ + c0 + 256 * i);
                v[i][0] = ALPHA * xv[0] + p1 * bf_lo(w1.x) + p2 * bf_lo(w2.x); v[i][1] = ALPHA * xv[1] + p1 * bf_hi(w1.x) + p2 * bf_hi(w2.x);
                v[i][2] = ALPHA * xv[2] + p1 * bf_lo(w1.y) + p2 * bf_lo(w2.y); v[i][3] = ALPHA * xv[3] + p1 * bf_hi(w1.y) + p2 * bf_hi(w2.y); }
        }
        float s = 0.f;
#pragma unroll
        for (int i = 0; i < 4; ++i) s += (v[i][0] + v[i][1]) + (v[i][2] + v[i][3]);
        const float mean = wave_sum(s) * (1.0f / D_);
        float q = 0.f;
#pragma unroll
        for (int i = 0; i < 4; ++i) { const f32x4 d = v[i] - mean; q += (d[0] * d[0] + d[1] * d[1]) + (d[2] * d[2] + d[3] * d[3]); }
        const float rstd = rsqrtf(wave_sum(q) * (1.0f / D_) + LN_EPS);
#pragma unroll
        for (int i = 0; i < 4; ++i) { const f32x4 o = (v[i] - mean) * rstd * gv[i] + bv[i];
            *(f32x4*)(xo + (size_t)row * D_ + c0 + 256 * i) = o;
            if (xb) { u32x2 w; w.x = pk_bf16(o[0], o[1]); w.y = pk_bf16(o[2], o[3]); *(u32x2*)(xb + (size_t)row * D_ + c0 + 256 * i) = w; } }
    }
}

__device__ __forceinline__ void ph_convgate(const Ctx& X) {
    const bf16_t* bcv = X.w<bf16_t>(A0_BCV); bf16_t* ya = X.w<bf16_t>(A0_YA); const float* cw = X.in(7);
    for (int i = X.bid * NTHREADS + X.tid; i < T_ * 128; i += X.G * NTHREADS) {
        const int t = i >> 7, c8 = (i & 127) * 8, s = t & (S_ - 1);
        float acc[8];
#pragma unroll
        for (int j = 0; j < 8; ++j) acc[j] = 0.f;
#pragma unroll
        for (int k = 0; k < 3; ++k) { const int dt = 2 - k;
            if (s - dt >= 0) { const bf16_t* rowp = bcv + (size_t)(t - dt) * 3072;
                const u32x4 cc = *(const u32x4*)(rowp + 1024 + c8), vv = *(const u32x4*)(rowp + 2048 + c8);
                const f32x4 w0 = *(const f32x4*)(cw + k * 1024 + c8), w1 = *(const f32x4*)(cw + k * 1024 + c8 + 4);
                const unsigned cw4[4] = {cc.x, cc.y, cc.z, cc.w}, vw4[4] = {vv.x, vv.y, vv.z, vv.w};
#pragma unroll
                for (int j = 0; j < 4; ++j) { const float wl = j < 2 ? w0[2 * j] : w1[2 * j - 4], wh = j < 2 ? w0[2 * j + 1] : w1[2 * j - 3];
                    acc[2 * j] += wl * (bf_lo(cw4[j]) * bf_lo(vw4[j])); acc[2 * j + 1] += wh * (bf_hi(cw4[j]) * bf_hi(vw4[j])); } } }
        const u32x4 bb = *(const u32x4*)(bcv + (size_t)t * 3072 + c8); const unsigned bw[4] = {bb.x, bb.y, bb.z, bb.w};
        u32x4 o; unsigned ow[4];
#pragma unroll
        for (int j = 0; j < 4; ++j) ow[j] = pk_bf16(bf_lo(bw[j]) * acc[2 * j], bf_hi(bw[j]) * acc[2 * j + 1]);
        o.x = ow[0]; o.y = ow[1]; o.z = ow[2]; o.w = ow[3];
        *(u32x4*)(ya + (size_t)t * D_ + c8) = o;
    }
}

__device__ __forceinline__ void ph_rwkv_mix(const Ctx& X) {
    const float* x = X.w<float>(OFF_X); const float* mix = X.in(9); bf16_t* xm = X.w<bf16_t>(A1_XMIX);
    for (int i = X.bid * NTHREADS + X.tid; i < T_ * 256; i += X.G * NTHREADS) {
        const int t = i >> 8, c4 = (i & 255) * 4, s = t & (S_ - 1);
        const f32x4 cur = *(const f32x4*)(x + (size_t)t * D_ + c4);
        const f32x4 prv = s > 0 ? *(const f32x4*)(x + (size_t)(t - 1) * D_ + c4) : (f32x4){0.f, 0.f, 0.f, 0.f};
        const f32x4 xx = prv - cur;
#pragma unroll
        for (int j = 0; j < 6; ++j) { const f32x4 m = *(const f32x4*)(mix + j * D_ + c4); const f32x4 o = cur + xx * m;
            u32x2 w; w.x = pk_bf16(o[0], o[1]); w.y = pk_bf16(o[2], o[3]); *(u32x2*)(xm + (size_t)j * T_ * D_ + (size_t)t * D_ + c4) = w; }
    }
}

constexpr int RW_TC = 32;
__device__ __forceinline__ void ph_rwkv_scan(const Ctx& X) {
    const bf16_t* rkv = X.w<bf16_t>(A1_RKV); const float* o3 = X.w<float>(A1_O3); float* yout = X.w<float>(A1_Y);
    const float* k_k = X.in(21); const float* k_a = X.in(22);
    LAS float* buf = (LAS float*)X.lds;
    LAS float* vbuf = buf + 2 * RW_TC * 320;
    LAS float* ybuf = vbuf + 2 * RW_TC * 32;
    const int tid = X.tid, row = tid >> 4, seg = tid & 15;
    for (int unit = X.bid; unit < 256; unit += X.G) {
        const int bh = unit >> 1, half = unit & 1, b = bh >> 4, h = bh & 15;
        const int tl = tid >> 4, ks = tid & 15, col = h * 64 + ks * 4;
        const f32x4 kkv = *(const f32x4*)(k_k + col), kav = *(const f32x4*)(k_a + col);
        const int tvl = tid >> 3, vs = tid & 7;
        f32x2 s01 = {0.f, 0.f}, s23 = {0.f, 0.f};
        u32x2 raw_r, raw_k, raw_v = {0u, 0u}; f32x4 raw_d, raw_a;
        __syncthreads();
#define RW_LOAD(ch) do { const size_t tok = (size_t)b * S_ + (size_t)(ch) * RW_TC + tl; \
            raw_r = *(const u32x2*)(rkv + tok * D_ + col); raw_k = *(const u32x2*)(rkv + (size_t)T_ * D_ + tok * D_ + col); \
            raw_d = *(const f32x4*)(o3 + tok * D_ + col); raw_a = *(const f32x4*)(o3 + (size_t)T_ * D_ + tok * D_ + col); \
            if (tid < 256) { const size_t tokv = (size_t)b * S_ + (size_t)(ch) * RW_TC + tvl; raw_v = *(const u32x2*)(rkv + (size_t)2 * T_ * D_ + tokv * D_ + h * 64 + half * 32 + vs * 4); } } while (0)
#define RW_PUT(pb) do { const f32x4 k4 = {bf_lo(raw_k.x), bf_hi(raw_k.x), bf_lo(raw_k.y), bf_hi(raw_k.y)}; const f32x4 r4 = {bf_lo(raw_r.x), bf_hi(raw_r.x), bf_lo(raw_r.y), bf_hi(raw_r.y)}; \
            f32x4 kn = k4 * kkv; const float n2 = allreduce16((kn[0] * kn[0] + kn[1] * kn[1]) + (kn[2] * kn[2] + kn[3] * kn[3])); \
            const float inv = 1.0f / fmaxf(sqrtf(n2), 1e-12f); kn = kn * inv; \
            const f32x4 kp = k4 * (1.0f + (raw_a - 1.0f) * kav); \
            LAS float* q = buf + ((pb) * RW_TC + tl) * 320 + ks * 4; \
            *(LAS f32x4*)(q) = raw_d; *(LAS f32x4*)(q + 64) = kp; *(LAS f32x4*)(q + 128) = -kn; *(LAS f32x4*)(q + 192) = kn * raw_a; *(LAS f32x4*)(q + 256) = r4; \
            if (tid < 256) { const f32x4 v4 = {bf_lo(raw_v.x), bf_hi(raw_v.x), bf_lo(raw_v.y), bf_hi(raw_v.y)}; *(LAS f32x4*)(vbuf + ((pb) * RW_TC + tvl) * 32 + vs * 4) = v4; } } while (0)
        RW_LOAD(0); RW_PUT(0);
        __syncthreads();
        constexpr int NCH = S_ / RW_TC;
        for (int ch = 0; ch < NCH; ++ch) {
            const int pb = ch & 1;
            if (ch + 1 < NCH) RW_LOAD(ch + 1);
            const LAS float* bb = buf + pb * RW_TC * 320 + seg * 4; const LAS float* vb = vbuf + pb * RW_TC * 32 + row; LAS float* yb = ybuf + pb * RW_TC * 32 + row;
#pragma unroll 4
            for (int t = 0; t < RW_TC; ++t) {
                const f32x4 w = *(const LAS f32x4*)(bb + t * 320), kp = *(const LAS f32x4*)(bb + t * 320 + 64), as = *(const LAS f32x4*)(bb + t * 320 + 128);
                const f32x4 bs = *(const LAS f32x4*)(bb + t * 320 + 192), r4 = *(const LAS f32x4*)(bb + t * 320 + 256);
                const float v = vb[t * 32];
                const f32x2 p = s01 * (f32x2){as[0], as[1]} + s23 * (f32x2){as[2], as[3]};
                const float sa = allreduce16(p.x + p.y);
                s01 = s01 * (f32x2){w[0], w[1]} + ((f32x2){bs[0], bs[1]} * sa + (f32x2){kp[0], kp[1]} * v);
                s23 = s23 * (f32x2){w[2], w[3]} + ((f32x2){bs[2], bs[3]} * sa + (f32x2){kp[2], kp[3]} * v);
                const f32x2 yq = s01 * (f32x2){r4[0], r4[1]} + s23 * (f32x2){r4[2], r4[3]};
                const float y = allreduce16(yq.x + yq.y);
                if (seg == 0) yb[t * 32] = y;
            }
            if (ch + 1 < NCH) RW_PUT(pb ^ 1);
            __syncthreads();
            { const int t = tid >> 4, rr = (tid & 15) * 2; const f32x2 yy = *(const LAS f32x2*)(ybuf + (pb * RW_TC + t) * 32 + rr);
              *(f32x2*)(yout + ((size_t)b * S_ + (size_t)ch * RW_TC + t) * D_ + h * 64 + half * 32 + rr) = yy; }
        }
#undef RW_LOAD
#undef RW_PUT
    }
}

__device__ __forceinline__ void ph_rwkv_post(const Ctx& X) {
    const bf16_t* rkv = X.w<bf16_t>(A1_RKV); const float* o3 = X.w<float>(A1_O3); const float* y = X.w<float>(A1_Y); bf16_t* yb = X.w<bf16_t>(A1_YB);
    const float* k_a = X.in(22); const float* r_k = X.in(23); const float* gn_g = X.in(24); const float* gn_b = X.in(25);
    const int c4 = (X.tid & 255) * 4;
    const f32x4 kav = *(const f32x4*)(k_a + c4), rkk = *(const f32x4*)(r_k + c4), gg = *(const f32x4*)(gn_g + c4), gb = *(const f32x4*)(gn_b + c4);
    for (int t = X.bid * 2 + (X.tid >> 8); t < T_; t += X.G * 2) {
        const size_t o = (size_t)t * D_ + c4;
        const f32x4 yv = *(const f32x4*)(y + o), av = *(const f32x4*)(o3 + (size_t)T_ * D_ + o), gv = *(const f32x4*)(o3 + (size_t)2 * T_ * D_ + o);
        const u32x2 rw = *(const u32x2*)(rkv + o), kw = *(const u32x2*)(rkv + (size_t)T_ * D_ + o), vw = *(const u32x2*)(rkv + (size_t)2 * T_ * D_ + o);
        const f32x4 r4 = {bf_lo(rw.x), bf_hi(rw.x), bf_lo(rw.y), bf_hi(rw.y)}, k4 = {bf_lo(kw.x), bf_hi(kw.x), bf_lo(kw.y), bf_hi(kw.y)}, v4 = {bf_lo(vw.x), bf_hi(vw.x), bf_lo(vw.y), bf_hi(vw.y)};
        const f32x4 kp = k4 * (1.0f + (av - 1.0f) * kav);
        const float mu = allreduce16((yv[0] + yv[1]) + (yv[2] + yv[3])) * (1.0f / 64.0f);
        const f32x4 d = yv - mu;
        const float var = allreduce16((d[0] * d[0] + d[1] * d[1]) + (d[2] * d[2] + d[3] * d[3])) * (1.0f / 64.0f);
        const f32x4 rk = r4 * kp * rkk;
        const float bonus = allreduce16((rk[0] + rk[1]) + (rk[2] + rk[3]));
        const f32x4 out = (d * rsqrtf(var + 64e-5f) * gg + gb + v4 * bonus) * gv;
        u32x2 w; w.x = pk_bf16(out[0], out[1]); w.y = pk_bf16(out[2], out[3]); *(u32x2*)(yb + o) = w;
    }
}

__device__ __forceinline__ void ph_route(const Ctx& X, const float* x, const float* wr, unsigned* cnt, int* route) {
    LAS float* wl = (LAS float*)X.lds;
    LAS int* lcnt = (LAS int*)(X.lds + 32768);
    LAS int* ltok = (LAS int*)(X.lds + 32768 + 64);
    for (int i = X.tid; i < 8192; i += NTHREADS) wl[i] = wr[i];
    if (X.tid < 16) lcnt[X.tid] = 0;
    __syncthreads();
    const int per = (T_ + X.G - 1) / X.G;
    const int t0 = X.bid * per, t1 = (t0 + per) < T_ ? (t0 + per) : T_;
    for (int t = t0 + X.wave; t < t1; t += 8) {
        float acc[8];
#pragma unroll
        for (int e = 0; e < 8; ++e) acc[e] = 0.f;
#pragma unroll
        for (int i = 0; i < 4; ++i) { const f32x4 xv = *(const f32x4*)(x + (size_t)t * D_ + X.lane * 4 + 256 * i);
#pragma unroll
            for (int j = 0; j < 4; ++j) { const LAS float* wp = wl + (X.lane * 4 + 256 * i + j) * 8; const f32x4 wa = *(const LAS f32x4*)wp, wb = *(const LAS f32x4*)(wp + 4);
                acc[0] += xv[j] * wa[0]; acc[1] += xv[j] * wa[1]; acc[2] += xv[j] * wa[2]; acc[3] += xv[j] * wa[3];
                acc[4] += xv[j] * wb[0]; acc[5] += xv[j] * wb[1]; acc[6] += xv[j] * wb[2]; acc[7] += xv[j] * wb[3]; } }
#pragma unroll
        for (int e = 0; e < 8; ++e) acc[e] = wave_sum(acc[e]);
        if (X.lane == 0) {
            int e1 = 0; float v1 = acc[0];
#pragma unroll
            for (int e = 1; e < 8; ++e) if (acc[e] > v1) { v1 = acc[e]; e1 = e; }
            int e2 = -1; float v2 = -3.0e38f;
#pragma unroll
            for (int e = 0; e < 8; ++e) if (e != e1 && acc[e] > v2) { v2 = acc[e]; e2 = e; }
            if (e2 < 0) { e2 = (e1 + 1) & 7; v2 = acc[e2]; }
            const float p1 = 1.0f / (1.0f + __expf(v2 - v1)), p2 = 1.0f - p1;
            const int li1 = atomicAdd((int*)(lcnt + e1), 1), li2 = atomicAdd((int*)(lcnt + e2), 1);
            LAS int* q = ltok + (t - t0) * 6; q[0] = e1; q[1] = e2; q[2] = li1; q[3] = li2; q[4] = __float_as_int(p1); q[5] = __float_as_int(p2);
        }
    }
    __syncthreads();
    if (X.tid < 8) lcnt[8 + X.tid] = (int)__hip_atomic_fetch_add(cnt + X.tid, (unsigned)lcnt[X.tid], __ATOMIC_RELAXED, __HIP_MEMORY_SCOPE_AGENT);
    __syncthreads();
    for (int i = X.tid; i < t1 - t0; i += NTHREADS) { const LAS int* q = ltok + i * 6; int* o = route + (size_t)(t0 + i) * 8;
        o[0] = q[0]; o[1] = q[1]; o[2] = lcnt[8 + q[0]] + q[2]; o[3] = lcnt[8 + q[1]] + q[3]; o[4] = q[4]; o[5] = q[5]; }
    __syncthreads();
}

__device__ __forceinline__ int moe_jobs(const Ctx& X, const unsigned* cnt, const bf16_t* A, int lda_elems, const bf16_t* W, size_t w_stride, int nN, int nt) {
    LAS int* total_p = (LAS int*)(X.lds + MISC_OFF + 512);
    if (X.tid == 0) { int off = 0, base = 0;
        for (int e = 0; e < 8; ++e) { const int c = (int)__hip_atomic_load(cnt + e, __ATOMIC_RELAXED, __HIP_MEMORY_SCOPE_AGENT), nM = (c + 255) >> 8;
            set_job(X, e, A + (size_t)off * lda_elems, W + (size_t)e * w_stride, nM, nN, nt, base, off); off += nM * 256; base += nM * nN; }
        *total_p = base; }
    __syncthreads();
    return *total_p;
}
__device__ __forceinline__ void ph_gather(const Ctx& X, const unsigned* cnt, int* route) {
    LAS int* offs = (LAS int*)X.lds;
    if (X.tid == 0) { int off = 0; for (int e = 0; e < 8; ++e) { const int c = (int)__hip_atomic_load(cnt + e, __ATOMIC_RELAXED, __HIP_MEMORY_SCOPE_AGENT); offs[e] = off; offs[8 + e] = c; off += ((c + 255) >> 8) << 8; } }
    __syncthreads();
    const bf16_t* xb = X.w<bf16_t>(OFF_XB); bf16_t* xg = X.w<bf16_t>(AM_XG);
    for (int t = X.bid * 8 + X.wave; t < T_; t += X.G * 8) {
        const int e1 = route[t * 8 + 0], e2 = route[t * 8 + 1], s1 = offs[e1] + route[t * 8 + 2], s2 = offs[e2] + route[t * 8 + 3];
        const u32x4 a = *(const u32x4*)(xb + (size_t)t * D_ + X.lane * 8), b = *(const u32x4*)(xb + (size_t)t * D_ + 512 + X.lane * 8);
        *(u32x4*)(xg + (size_t)s1 * D_ + X.lane * 8) = a; *(u32x4*)(xg + (size_t)s1 * D_ + 512 + X.lane * 8) = b;
        *(u32x4*)(xg + (size_t)s2 * D_ + X.lane * 8) = a; *(u32x4*)(xg + (size_t)s2 * D_ + 512 + X.lane * 8) = b;
        if (X.lane == 0) { route[t * 8 + 6] = s1; route[t * 8 + 7] = s2; }
    }
    for (int e = 0; e < 8; ++e) { const int c = offs[8 + e], r0 = offs[e] + c, r1 = offs[e] + (((c + 255) >> 8) << 8);
        for (int r = r0 + X.bid * 8 + X.wave; r < r1; r += X.G * 8) { const u32x4 z = {0u, 0u, 0u, 0u};
            *(u32x4*)(xg + (size_t)r * D_ + X.lane * 8) = z; *(u32x4*)(xg + (size_t)r * D_ + 512 + X.lane * 8) = z; } }
    __syncthreads();
}

__device__ __forceinline__ void ph_conv4(const Ctx& X) {
    const bf16_t* uu = X.w<bf16_t>(A2_UU); bf16_t* uc = X.w<bf16_t>(A2_UC); const float* cw = X.in(28); const float* cb = X.in(29);
    for (int i = X.bid * NTHREADS + X.tid; i < T_ * 160; i += X.G * NTHREADS) {
        const int t = i / 160, c8 = (i % 160) * 8, s = t & (S_ - 1);
        float acc[8];
        { const f32x4 b0 = *(const f32x4*)(cb + c8), b1 = *(const f32x4*)(cb + c8 + 4);
#pragma unroll
          for (int j = 0; j < 4; ++j) { acc[j] = b0[j]; acc[4 + j] = b1[j]; } }
#pragma unroll
        for (int k = 0; k < 4; ++k) { const int dt = 3 - k;
            if (s - dt >= 0) { const u32x4 uv = *(const u32x4*)(uu + (size_t)(t - dt) * DRNN + c8); const unsigned uw[4] = {uv.x, uv.y, uv.z, uv.w};
                const f32x4 w0 = *(const f32x4*)(cw + k * DRNN + c8), w1 = *(const f32x4*)(cw + k * DRNN + c8 + 4);
                acc[0] += w0[0] * bf_lo(uw[0]); acc[1] += w0[1] * bf_hi(uw[0]); acc[2] += w0[2] * bf_lo(uw[1]); acc[3] += w0[3] * bf_hi(uw[1]);
                acc[4] += w1[0] * bf_lo(uw[2]); acc[5] += w1[1] * bf_hi(uw[2]); acc[6] += w1[2] * bf_lo(uw[3]); acc[7] += w1[3] * bf_hi(uw[3]); } }
        u32x4 o; o.x = pk_bf16(acc[0], acc[1]); o.y = pk_bf16(acc[2], acc[3]); o.z = pk_bf16(acc[4], acc[5]); o.w = pk_bf16(acc[6], acc[7]);
        *(u32x4*)(uc + (size_t)t * DRNN + c8) = o;
    }
}

__device__ __forceinline__ void ph_lru_scan(const Ctx& X) {
    const float* at = X.w<float>(A2_AT); const float* bt = X.w<float>(A2_BT); const bf16_t* gg = X.w<bf16_t>(A2_GG); bf16_t* yc = X.w<bf16_t>(A2_YC);
    LAS float* agg = (LAS float*)X.lds;
    const int sg = X.tid >> 6, cl = X.tid & 63;
    for (int unit = X.bid; unit < 8 * 20; unit += X.G) {
        const int b = unit / 20, ch = (unit % 20) * 64 + cl;
        const size_t base = ((size_t)b * S_ + (size_t)sg * 256) * DRNN + ch;
        float A = 1.f, H = 0.f;
#pragma unroll 8
        for (int t = 0; t < 256; ++t) { const float a = at[base + (size_t)t * DRNN], bb = bt[base + (size_t)t * DRNN]; H = a * H + bb; A *= a; }
        __syncthreads();
        agg[(sg * 2 + 0) * 64 + cl] = A; agg[(sg * 2 + 1) * 64 + cl] = H;
        __syncthreads();
        float hin = 0.f;
        for (int s2 = 0; s2 < sg; ++s2) hin = agg[(s2 * 2 + 0) * 64 + cl] * hin + agg[(s2 * 2 + 1) * 64 + cl];
        float h = hin;
#pragma unroll 8
        for (int t = 0; t < 256; ++t) { const float a = at[base + (size_t)t * DRNN], bb = bt[base + (size_t)t * DRNN]; h = a * h + bb;
            const float g = bf1(gg[base + (size_t)t * DRNN]); const unsigned w = pk_bf16(g * h, 0.f); yc[base + (size_t)t * DRNN] = (bf16_t)(w & 0xffffu); }
    }
    __syncthreads();
}

__device__ __forceinline__ void ph_ret_post(const Ctx& X) {
    const bf16_t* y = X.w<bf16_t>(A3_Y); const bf16_t* gs = X.w<bf16_t>(A3_GS); bf16_t* yd = X.w<bf16_t>(A3_YD);
    for (int i = X.bid * 8 + X.wave; i < T_ * 4; i += X.G * 8) {
        const size_t o = (size_t)i * 512 + X.lane * 8;
        const u32x4 yw = *(const u32x4*)(y + o), gw = *(const u32x4*)(gs + o);
        const unsigned ya[4] = {yw.x, yw.y, yw.z, yw.w}, ga[4] = {gw.x, gw.y, gw.z, gw.w};
        float v[8], q = 0.f;
#pragma unroll
        for (int j = 0; j < 4; ++j) { v[2 * j] = bf_lo(ya[j]); v[2 * j + 1] = bf_hi(ya[j]); q += v[2 * j] * v[2 * j] + v[2 * j + 1] * v[2 * j + 1]; }
        const float rs = rsqrtf(wave_sum(q) * (1.0f / 512.0f) + 1e-6f);
        u32x4 ow; unsigned oa[4];
#pragma unroll
        for (int j = 0; j < 4; ++j) oa[j] = pk_bf16(v[2 * j] * rs * bf_lo(ga[j]), v[2 * j + 1] * rs * bf_hi(ga[j]));
        ow.x = oa[0]; ow.y = oa[1]; ow.z = oa[2]; ow.w = oa[3];
        *(u32x4*)(yd + o) = ow;
    }
}

template <class Epi>
__device__ __forceinline__ void gemm1(const Ctx& X, const void* A, int lda, const void* Bt, int ldb, int nM, int nN, int K, const Epi& E) {
    __syncthreads();
    if (X.tid == 0) set_job(X, 0, A, Bt, nM, nN, K / 64, 0, 0);
    __syncthreads();
    const pg8::JobSched S = make_sched(X, 1, nM * nN, lda, ldb);
    pg8::gemm_phase(X.lds, lda, ldb, S, E);
    __syncthreads();
}

__device__ __forceinline__ void ph_ffn_gu(const Ctx& X, int l) { EpiSwiglu E{X.w<bf16_t>(AF_H), DFF}; gemm1(X, X.w<bf16_t>(OFF_XB), D_, X.w<bf16_t>(OFF_WF_GU) + (size_t)l * 5632 * 1024, D_, 64, 22, D_, E); }
__device__ __forceinline__ void ph_ffn_dn(const Ctx& X, int l, const float* xres) { EpiResid E{xres, X.w<float>(OFF_PRE)}; gemm1(X, X.w<bf16_t>(AF_H), DFF, X.w<bf16_t>(OFF_WF_DN) + (size_t)l * 1024 * 2816, DFF, 64, 4, DFF, E); }
__device__ __forceinline__ void ph_moe_gu(const Ctx& X, int l) {
    __syncthreads();
    const int total = moe_jobs(X, (const unsigned*)X.ws + CTL_MOE_CNT + l * 64, X.w<bf16_t>(AM_XG), D_, X.w<bf16_t>(OFF_WM_GU) + (size_t)l * 8 * 7168 * 1024, (size_t)7168 * 1024, 28, 16);
    EpiSwiglu E{X.w<bf16_t>(AM_H), DFE}; const pg8::JobSched S = make_sched(X, 8, total, D_, D_);
    pg8::gemm_phase(X.lds, D_, D_, S, E); __syncthreads();
}
__device__ __forceinline__ void ph_moe_dn(const Ctx& X, int l) {
    __syncthreads();
    const int total = moe_jobs(X, (const unsigned*)X.ws + CTL_MOE_CNT + l * 64, X.w<bf16_t>(AM_H), DFE, X.w<bf16_t>(OFF_WM_DN) + (size_t)l * 8 * 1024 * 3584, (size_t)1024 * 3584, 4, 56);
    EpiStoreBf16 E{X.w<bf16_t>(AM_O), D_}; const pg8::JobSched S = make_sched(X, 8, total, DFE, DFE);
    pg8::gemm_phase(X.lds, DFE, DFE, S, E); __syncthreads();
}

constexpr int N_PHASES = 40;
__global__ void __launch_bounds__(NTHREADS, 2) mega(Params p) {
    extern __shared__ __attribute__((aligned(16))) unsigned char lds_raw[];
    Ctx X; X.p = &p; X.ws = p.ws; X.lds = (LAS unsigned char*)lds_raw; X.tid = threadIdx.x; X.lane = X.tid & 63; X.wave = rfl(X.tid >> 6); X.G = gridDim.x; X.bid = blockIdx.x;
    const int lo = p.ph_lo, hi = p.ph_hi;
    if (X.tid < 4) ((LAS unsigned*)(X.lds + MISC_OFF))[X.tid] = 0u;
    __syncthreads();
    XcdBarrier bar; bar.bar = (unsigned*)X.ws; bar.x = 0; bar.st = (volatile LAS unsigned*)(X.lds + MISC_OFF);
    if (hi - lo > 1) bar = xcd_barrier_post((unsigned*)X.ws, (volatile LAS unsigned*)(X.lds + MISC_OFF));
#define PH(k, ...) if (lo <= (k) && (k) < hi) { __VA_ARGS__; if ((k) + 1 < hi) xcd_barrier(bar); }
    float* xs = X.w<float>(OFF_X); bf16_t* xb = X.w<bf16_t>(OFF_XB); float* pre = X.w<float>(OFF_PRE);
    unsigned* ctl = (unsigned*)X.ws; int* route = X.w<int>(OFF_ROUTE);
    const float* lmg = X.in(2); const float* lmb = X.in(3); const float* lfg = X.in(4); const float* lfb = X.in(5);

    PH(0, ph_prologue(X));
    PH(1, { EpiStoreBf16 E{X.w<bf16_t>(A0_BCV), 3072}; gemm1(X, xb, D_, X.w<bf16_t>(OFF_WA_IN), D_, 64, 12, D_, E); });
    PH(2, ph_convgate(X));
    PH(3, { EpiResid E{X.in(0), pre}; gemm1(X, X.w<bf16_t>(A0_YA), D_, X.w<bf16_t>(OFF_WA_OUT), D_, 64, 4, D_, E); });
    PH(4, ph_ln<false>(X, pre, lmg, lmb, xs, xb, nullptr, nullptr, nullptr));
    PH(5, ph_ffn_gu(X, 0));
    PH(6, ph_ffn_dn(X, 0, xs));
    PH(7, ph_ln<false>(X, pre, lfg, lfb, xs, xb, nullptr, nullptr, nullptr));
    PH(8, ph_rwkv_mix(X));
    PH(9, { __syncthreads();
            if (X.tid == 0) { const bf16_t* xm = X.w<bf16_t>(A1_XMIX); const bf16_t* wr = X.w<bf16_t>(OFF_WB_RKV); const bf16_t* w1 = X.w<bf16_t>(OFF_WB_L1);
                set_job(X, 0, xm + (size_t)0 * T_ * D_, wr + (size_t)0 * D_ * D_, 64, 4, 16, 0, 0);
                set_job(X, 1, xm + (size_t)2 * T_ * D_, wr + (size_t)1 * D_ * D_, 64, 4, 16, 256, 0);
                set_job(X, 2, xm + (size_t)3 * T_ * D_, wr + (size_t)2 * D_ * D_, 64, 4, 16, 512, 0);
                set_job(X, 3, xm + (size_t)1 * T_ * D_, w1 + (size_t)0 * 256 * D_, 64, 1, 16, 768, 0);
                set_job(X, 4, xm + (size_t)4 * T_ * D_, w1 + (size_t)1 * 256 * D_, 64, 1, 16, 832, 0);
                set_job(X, 5, xm + (size_t)5 * T_ * D_, w1 + (size_t)2 * 256 * D_, 64, 1, 16, 896, 0); }
            __syncthreads();
            EpiRwkv1 E{X.w<bf16_t>(A1_RKV), X.w<bf16_t>(A1_L1)}; const pg8::JobSched S = make_sched(X, 6, 960, D_, D_);
            pg8::gemm_phase(X.lds, D_, D_, S, E); __syncthreads(); });
    PH(10, { __syncthreads();
             if (X.tid == 0) { const bf16_t* l1 = X.w<bf16_t>(A1_L1); const bf16_t* w2 = X.w<bf16_t>(OFF_WB_L2);
                 for (int j = 0; j < 3; ++j) set_job(X, j, l1 + (size_t)j * T_ * 256, w2 + (size_t)j * 1024 * 256, 64, 4, 4, 256 * j, 0); }
             __syncthreads();
             EpiRwkv2 E{X.w<float>(A1_O3), X.in(13), X.in(16)}; const pg8::JobSched S = make_sched(X, 3, 768, 256, 256);
             pg8::gemm_phase(X.lds, 256, 256, S, E); __syncthreads(); });
    PH(11, ph_rwkv_scan(X));
    PH(12, ph_rwkv_post(X));
    PH(13, { EpiResid E{xs, pre}; gemm1(X, X.w<bf16_t>(A1_YB), D_, X.w<bf16_t>(OFF_WB_O), D_, 64, 4, D_, E); });
    PH(14, ph_ln<false>(X, pre, lmg + D_, lmb + D_, xs, xb, nullptr, nullptr, nullptr));
    PH(15, ph_route(X, xs, X.in(40), ctl + CTL_MOE_CNT, route));
    PH(16, ph_gather(X, ctl + CTL_MOE_CNT, route));
    PH(17, ph_moe_gu(X, 0));
    PH(18, ph_moe_dn(X, 0));
    PH(19, ph_ln<true>(X, nullptr, lfg + D_, lfb + D_, xs, xb, xs, X.w<bf16_t>(AM_O), route));
    PH(20, { EpiGriffinIn E{X.w<bf16_t>(A2_GG), X.w<bf16_t>(A2_UU)}; gemm1(X, xb, D_, X.w<bf16_t>(OFF_WC_IN), D_, 64, 10, D_, E); });
    PH(21, ph_conv4(X));
    PH(22, { __syncthreads();
             if (X.tid == 0) { const bf16_t* uc = X.w<bf16_t>(A2_UC); const bf16_t* wg = X.w<bf16_t>(OFF_WC_G);
                 for (int j = 0; j < 5; ++j) set_job(X, j, uc + j * 256, wg + (size_t)j * 512 * 256, 64, 2, 4, 128 * j, 0); }
             __syncthreads();
             EpiGates E{X.w<bf16_t>(A2_UC), X.in(31), X.in(33), X.in(34), (const int*)X.in(1), X.w<float>(A2_AT), X.w<float>(A2_BT)};
             const pg8::JobSched S = make_sched(X, 5, 640, DRNN, 256);
             pg8::gemm_phase(X.lds, DRNN, 256, S, E); __syncthreads(); });
    PH(23, ph_lru_scan(X));
    PH(24, { EpiResid E{xs, pre}; gemm1(X, X.w<bf16_t>(A2_YC), DRNN, X.w<bf16_t>(OFF_WC_OUT), DRNN, 64, 4, DRNN, E); });
    PH(25, ph_ln<false>(X, pre, lmg + 2 * D_, lmb + 2 * D_, xs, xb, nullptr, nullptr, nullptr));
    PH(26, ph_ffn_gu(X, 1));
    PH(27, ph_ffn_dn(X, 1, xs));
    PH(28, ph_ln<false>(X, pre, lfg + 2 * D_, lfb + 2 * D_, xs, xb, nullptr, nullptr, nullptr));
    PH(29, { __syncthreads();
             if (X.tid == 0) { const bf16_t* wd = X.w<bf16_t>(OFF_WD_IN);
                 set_job(X, 0, xb, wd, 64, 4, 16, 0, 0);
                 set_job(X, 1, xb, wd + (size_t)1024 * D_, 64, 4, 16, 256, 0);
                 set_job(X, 2, xb, wd + (size_t)4096 * D_, 64, 8, 16, 512, 0);
                 set_job(X, 3, wd + (size_t)2048 * D_, xb, 8, 64, 16, 1024, 0); }
             __syncthreads();
             const float* rc = X.w<float>(OFF_ROT);
             EpiRetIn E{X.w<bf16_t>(A3_QR), X.w<bf16_t>(A3_KR), X.w<bf16_t>(A3_GS), X.w<bf16_t>(A3_VT), rc, rc + (size_t)T_ * 128};
             const pg8::JobSched S = make_sched(X, 4, 1536, D_, D_);
             pg8::gemm_phase(X.lds, D_, D_, S, E); __syncthreads(); });
    PH(30, { __syncthreads(); EpiScores E{X.w<bf16_t>(A3_SC)}; ScoreSched S{(const char*)X.w<bf16_t>(A3_QR), (const char*)X.w<bf16_t>(A3_KR), X.G, X.bid};
             pg8::gemm_phase(X.lds, D_, D_, S, E); __syncthreads(); });
    PH(31, { __syncthreads(); EpiRetOut E{X.w<bf16_t>(A3_Y)}; RetOutSched S{(const char*)X.w<bf16_t>(A3_SC), (const char*)X.w<bf16_t>(A3_VT), X.G, X.bid};
             pg8::gemm_phase(X.lds, 2048, T_, S, E); __syncthreads(); });
    PH(32, ph_ret_post(X));
    PH(33, { EpiResid E{xs, pre}; gemm1(X, X.w<bf16_t>(A3_YD), 2048, X.w<bf16_t>(OFF_WD_O), 2048, 64, 4, 2048, E); });
    PH(34, ph_ln<false>(X, pre, lmg + 3 * D_, lmb + 3 * D_, xs, xb, nullptr, nullptr, nullptr));
    PH(35, ph_route(X, xs, X.in(40) + 8192, ctl + CTL_MOE_CNT + 64, route));
    PH(36, ph_gather(X, ctl + CTL_MOE_CNT + 64, route));
    PH(37, ph_moe_gu(X, 1));
    PH(38, ph_moe_dn(X, 1));
    PH(39, ph_ln<true>(X, nullptr, lfg + 3 * D_, lfb + 3 * D_, p.out, nullptr, xs, X.w<bf16_t>(AM_O), route));
#undef PH
}

extern "C" void kernel_launch(void* const* d_in, const int* in_sizes, int n_in, void* d_out, int out_size, void* d_ws, size_t ws_size, hipStream_t stream) {
    static int grid = 0;
    if (grid == 0) {
        if (n_in != 43 || ws_size < WS_NEED) { fprintf(stderr, "kernel_launch: need 43 inputs and %zu bytes of workspace (got %d, %zu)\n", (size_t)WS_NEED, n_in, ws_size); grid = -1; return; }
        int dev = 0, cus = 0, per_cu = 0;
        if (hipGetDevice(&dev) != hipSuccess || hipDeviceGetAttribute(&cus, hipDeviceAttributeMultiprocessorCount, dev) != hipSuccess) { grid = -1; return; }
        if (hipFuncSetAttribute((const void*)mega, hipFuncAttributeMaxDynamicSharedMemorySize, LDS_BYTES) != hipSuccess) { fprintf(stderr, "kernel_launch: hipFuncSetAttribute failed\n"); grid = -1; return; }
        if (hipOccupancyMaxActiveBlocksPerMultiprocessor(&per_cu, (const void*)mega, NTHREADS, LDS_BYTES) != hipSuccess || per_cu < 1) { fprintf(stderr, "kernel_launch: occupancy query says %d\n", per_cu); }
        (void)hipGetLastError();
        grid = cus;
    }
    if (grid < 0) return;
    (void)hipMemsetAsync(d_ws, 0, CTL_BYTES, stream);
    Params p{};
    for (int i = 0; i < 43; ++i) p.in[i] = (const float*)d_in[i];
    p.out = (float*)d_out; p.ws = (unsigned char*)d_ws;
#if MK_ONE_LAUNCH
    p.ph_lo = 0; p.ph_hi = N_PHASES;
    hipLaunchKernelGGL(mega, dim3(grid), dim3(NTHREADS), LDS_BYTES, stream, p);
#else
    for (int k = 0; k < N_PHASES; ++k) { p.ph_lo = k; p.ph_hi = k + 1; hipLaunchKernelGGL(mega, dim3(grid), dim3(NTHREADS), LDS_BYTES, stream, p); }
#endif
}
```
